# Optimizing an MI355X kernel written in HIP

```python
import jax, jax.numpy as jnp
from jax import lax
import numpy as np

D_MODEL = 1024
BATCH = 16
SEQ = 2048
DEPTH = 1

CHUNK = 64
D_HEAD = 64
A_HEADS = 8
A_PREV_CHUNKS = 8
MAX_REL = 128
B_Q_HEADS = 8
B_KV_HEADS = 2
B_GROUP = B_Q_HEADS // B_KV_HEADS
B_WINDOW = 128
B_PREV_CHUNKS = B_WINDOW // CHUNK
A_WIDTH = A_HEADS * D_HEAD
B_Q_WIDTH = B_Q_HEADS * D_HEAD
B_KV_WIDTH = B_KV_HEADS * D_HEAD
D_FF = 2816
REL_TABLE = (CHUNK - 1) + MAX_REL + 1
IN_WIDTH = 3 * A_WIDTH + B_Q_WIDTH + 2 * B_KV_WIDTH + 2 * D_MODEL
EPS = 1e-6
NEG_INF = -1e30

kernel_name = "streaming_hybrid_gated_chunk_attention_block"


def rms_norm(x, g):
    xf = x.astype(jnp.float32)
    y = xf * lax.rsqrt(jnp.mean(xf * xf, axis=-1, keepdims=True) + EPS)
    return y.astype(x.dtype) * g


def swiglu(h, w_gate, w_up, w_down):
    return (jax.nn.silu(h @ w_gate) * (h @ w_up)) @ w_down


def alibi_slopes(n):
    return np.array([2.0 ** (-8.0 * (i + 1) / n) for i in range(n)], dtype=np.float32)


def banded_chunk_attention(q, k, v, n_prev, bias, sinks=None):
    b, s, hkv, g, dh = q.shape
    n_chunks = s // CHUNK
    pad = n_prev * CHUNK
    band = (n_prev + 1) * CHUNK
    scale = 1.0 / np.sqrt(dh)
    kp = jnp.pad(k, ((0, 0), (pad, 0), (0, 0), (0, 0)))
    vp = jnp.pad(v, ((0, 0), (pad, 0), (0, 0), (0, 0)))
    key_off = jnp.arange(band)

    def one_chunk(c):
        start = c * CHUNK
        qc = lax.dynamic_slice_in_dim(q, start, CHUNK, axis=1)
        kc = lax.dynamic_slice_in_dim(kp, start, band, axis=1)
        vc = lax.dynamic_slice_in_dim(vp, start, band, axis=1)
        sc = jnp.einsum('bqhgd,bkhd->bhgqk', qc, kc).astype(jnp.float32) * scale + bias
        valid = (start - pad + key_off) >= 0
        sc = jnp.where(valid, sc, NEG_INF)
        if sinks is not None:
            sink_col = jnp.broadcast_to(sinks.astype(jnp.float32)[None, :, :, None, None],
                                        sc.shape[:-1] + (1,))
            p = jax.nn.softmax(jnp.concatenate([sc, sink_col], axis=-1), axis=-1)[..., :band]
        else:
            p = jax.nn.softmax(sc, axis=-1)
        return jnp.einsum('bhgqk,bkhd->bqhgd', p.astype(vc.dtype), vc)

    out = lax.map(one_chunk, jnp.arange(n_chunks))
    return jnp.moveaxis(out, 0, 1).reshape(b, s, hkv * g * dh)


def setup_inputs(seed: int = 0) -> dict:
    key = jax.random.key(seed)
    ks = jax.random.split(key, 20)
    f32 = jnp.float32

    def w(k, shape, fan_in):
        return jax.random.normal(k, shape, f32) * fan_in ** -0.5

    def gain(k):
        return 1.0 + 0.01 * jax.random.normal(k, (D_MODEL,), f32)

    return {
        "x": jax.random.normal(ks[0], (BATCH, SEQ, D_MODEL), f32),
        "ffn1_norm": gain(ks[1]),
        "ffn1_w_gate": w(ks[2], (D_MODEL, D_FF), D_MODEL),
        "ffn1_w_up": w(ks[3], (D_MODEL, D_FF), D_MODEL),
        "ffn1_w_down": w(ks[4], (D_FF, D_MODEL), D_FF),
        "mix_norm": gain(ks[5]),
        "w_in": w(ks[6], (D_MODEL, IN_WIDTH), D_MODEL),
        "rel_bias": 0.5 * jax.random.normal(ks[7], (A_HEADS, REL_TABLE), f32),
        "sinks": jax.random.normal(ks[8], (B_Q_HEADS,), f32),
        "w_proj_a": w(ks[9], (A_WIDTH, D_MODEL), A_WIDTH),
        "w_proj_b": w(ks[10], (B_Q_WIDTH, D_MODEL), B_Q_WIDTH),
        "w_out": w(ks[11], (D_MODEL, D_MODEL), D_MODEL),
        "ffn2_norm": gain(ks[12]),
        "ffn2_w_gate": w(ks[13], (D_MODEL, D_FF), D_MODEL),
        "ffn2_w_up": w(ks[14], (D_MODEL, D_FF), D_MODEL),
        "ffn2_w_down": w(ks[15], (D_FF, D_MODEL), D_FF),
        "final_norm": gain(ks[16]),
    }


def reference(x, ffn1_norm, ffn1_w_gate, ffn1_w_up, ffn1_w_down, mix_norm, w_in,
              rel_bias, sinks, w_proj_a, w_proj_b, w_out, ffn2_norm, ffn2_w_gate,
              ffn2_w_up, ffn2_w_down, final_norm):
    b, s, _ = x.shape

    qi = np.arange(CHUNK)[:, None]
    kj_a = np.arange((A_PREV_CHUNKS + 1) * CHUNK)[None, :]
    rel_a = qi - kj_a + A_PREV_CHUNKS * CHUNK
    idx_a = np.clip(rel_a, -(CHUNK - 1), MAX_REL) + (CHUNK - 1)
    kj_b = np.arange((B_PREV_CHUNKS + 1) * CHUNK)[None, :]
    dist_b = np.abs(qi - kj_b + B_PREV_CHUNKS * CHUNK).astype(np.float32)
    slopes = jnp.asarray(alibi_slopes(B_Q_HEADS)).reshape(B_KV_HEADS, B_GROUP)

    for _layer in range(DEPTH):
        x = x + 0.5 * swiglu(rms_norm(x, ffn1_norm), ffn1_w_gate, ffn1_w_up, ffn1_w_down)

        h = rms_norm(x, mix_norm)
        proj = h @ w_in
        cuts = np.cumsum([A_WIDTH, A_WIDTH, A_WIDTH, B_Q_WIDTH, B_KV_WIDTH, B_KV_WIDTH, D_MODEL])
        qa, ka, va, qb, kb, vb, gate_a, gate_b = jnp.split(proj, cuts, axis=-1)

        bias_a = rel_bias[:, idx_a].astype(jnp.float32)[:, None]
        ya = banded_chunk_attention(
            qa.reshape(b, s, A_HEADS, 1, D_HEAD),
            ka.reshape(b, s, A_HEADS, D_HEAD),
            va.reshape(b, s, A_HEADS, D_HEAD),
            A_PREV_CHUNKS, bias_a)
        ya = ya @ w_proj_a

        bias_b = -slopes[:, :, None, None] * jnp.asarray(dist_b)[None, None]
        yb = banded_chunk_attention(
            qb.reshape(b, s, B_KV_HEADS, B_GROUP, D_HEAD),
            kb.reshape(b, s, B_KV_HEADS, D_HEAD),
            vb.reshape(b, s, B_KV_HEADS, D_HEAD),
            B_PREV_CHUNKS, bias_b, sinks.reshape(B_KV_HEADS, B_GROUP))
        yb = yb @ w_proj_b

        merged = jax.nn.sigmoid(gate_a) * ya + jax.nn.sigmoid(gate_b) * yb
        x = x + merged @ w_out

        x = x + 0.5 * swiglu(rms_norm(x, ffn2_norm), ffn2_w_gate, ffn2_w_up, ffn2_w_down)

    return rms_norm(x, final_norm)
```

```cpp
#include <hip/hip_runtime.h>
#include <hip/hip_cooperative_groups.h>
#include <cstdio>
#include <cstdint>
namespace cg = cooperative_groups;
#define XN_TILED 0
#define T_TILED 0
#define O_TILED 0
#ifndef PROBE_DUP
#define PROBE_DUP -1
#endif
#define DUP(k) if constexpr (PROBE_DUP == (k))
namespace pg8 {
#define PG8_LAS __attribute__((address_space(3)))
typedef unsigned short bf16_t;
typedef short bf16x8 __attribute__((ext_vector_type(8)));
typedef float f32x4 __attribute__((ext_vector_type(4)));
typedef unsigned u32x4 __attribute__((ext_vector_type(4)));
constexpr int BM = 256, BK = 64, HALF = 128, HTB = HALF * BK * 2  , STAGE_BYTES = 8 * HTB, NXCD = 8, WGM = 8;

__host__ __device__ __forceinline__ int lds_byte(int r, int c) { const int st = (r >> 4) * 2 + (c >> 5), rr = r & 15, cc = c & 31, ob = rr * 64 + cc * 2; return st * 1024 + (ob ^ (((ob >> 9) & 1) << 5)); }
__host__ __device__ __forceinline__ void stage_rc(int b, int& R, int& C) { const int st = b / 1024, sb = b % 1024, swz = sb ^ (((sb >> 9) & 1) << 5); R = (st >> 1) * 16 + swz / 64; C = (st & 1) * 32 + (swz % 64) / 2; }
__host__ __device__ __forceinline__ int perm32(int rho) { const int n = rho >> 4, i = rho & 15; return 8 * (i >> 2) + 4 * n + (i & 3); }

struct Unit { int pm, pn; };
struct Gemm { const bf16_t* A; const bf16_t* Bt; int M, N, K; int tiledA, tiledB; };

struct StaticOrder {
    int nM, nN, nwg, G, c;
    __host__ __device__ void init(int M, int N, int G_, int c_) { nM = M / BM; nN = N / BM; nwg = nM * nN; G = G_; c = c_; }
    __host__ __device__ bool next(int i, Unit& u) const {
        const long L = (long)i * G + c; if (L >= nwg) return false;
        int wgid = (int)L; { const int q = nwg / NXCD, r = nwg % NXCD, xcd = wgid % NXCD, off = wgid / NXCD; wgid = (xcd < r ? xcd * (q + 1) : r * (q + 1) + (xcd - r) * q) + off; }
        const int nig = WGM * nN, gid = wgid / nig, fm = gid * WGM, gsz = (nM - fm) < WGM ? (nM - fm) : WGM;
        u.pm = fm + ((wgid % nig) % gsz); u.pn = (wgid % nig) / gsz; return true;
    }
    __device__ __forceinline__ void a_ready(const Unit&) const {}
    __device__ __forceinline__ void done(const Unit&) const {}
};
__device__ __forceinline__ unsigned cvt_pk_bf16(float lo, float hi) { unsigned r; asm volatile("v_cvt_pk_bf16_f32 %0, %1, %2" : "=v"(r) : "v"(lo), "v"(hi)); return r; }
typedef float f32x2 __attribute__((ext_vector_type(2)));
typedef unsigned u32x2 __attribute__((ext_vector_type(2)));
#ifndef XN_TILED
#define XN_TILED 0
#endif
#ifndef T_TILED
#define T_TILED 0
#endif
#ifndef O_TILED
#define O_TILED 0
#endif
__device__ __forceinline__ size_t tix(size_t row, int col, int ktiles, bool tiled = true) { return tiled ? ((((row >> 8) * ktiles + (col >> 6)) << 14) + ((row & 255) << 6)) + (col & 63) : row * (size_t)(64 * ktiles) + col; }
__device__ __forceinline__ float bf_lo(unsigned w) { return __uint_as_float(w << 16); }
__device__ __forceinline__ float bf_hi(unsigned w) { return __uint_as_float(w & 0xffff0000u); }
__device__ __forceinline__ float sigm(float x) { return __builtin_amdgcn_rcpf(1.0f + __builtin_amdgcn_exp2f(-1.4426950408889634f * x)); }
constexpr int PROJ_LD = 2304;
__device__ __forceinline__ size_t gidx(int stage, int pm, int pt, int rowp, int col) { return ((((size_t)stage * 128 + pm) * 4 + pt) * 256 + rowp) * 256 + col; }
constexpr float QSCALE = 0.125f * 1.4426950408889634f;

__device__ __forceinline__ float row_rstd(const float* SS, size_t row) {
    const f32x4* p = (const f32x4*)(SS + row * 16);
    const f32x4 a = p[0], b = p[1], c = p[2], d = p[3];
    const float s = ((a[0] + a[1]) + (a[2] + a[3])) + ((b[0] + b[1]) + (b[2] + b[3])) + ((c[0] + c[1]) + (c[2] + c[3])) + ((d[0] + d[1]) + (d[2] + d[3]));
    return 1.0f / sqrtf(s * (1.0f / 1024.0f) + 1e-6f);
}
struct RowScale {
    const float* SS; const PG8_LAS float* tab; int pmA;
    __device__ __forceinline__ float get(const Unit& u, size_t row) const { return tab ? tab[(u.pm != pmA ? 256 : 0) + (int)(row & 255)] : row_rstd(SS, row); }
};
template <bool SCALE> struct EpiSwiglu {
    static constexpr bool PERM = true, AFTER_DRAIN = false, PAIRED = false;
    bf16_t* H; int ldh; RowScale RS;
    __device__ __forceinline__ void operator()(const f32x4 (&acc)[2][2][4][2], const Unit& u, int wr, int wc, int fr, int fq) const {
        const int row0 = u.pm * BM + wr * 64 + fr, col0 = u.pn * HALF + wc * 32 + 8 * fq;
#pragma unroll
        for (int ai = 0; ai < 2; ++ai)
#pragma unroll
            for (int m = 0; m < 4; ++m) {
                const size_t row = (size_t)(row0 + ai * HALF + m * 16);
                bf16_t* p = H + ((size_t)(u.pm * (ldh >> 6) + (col0 >> 6)) * BM + (row & (BM - 1))) * BK + (col0 & 63);
                f32x4 g0 = acc[ai][0][m][0], g1 = acc[ai][0][m][1], u0 = acc[ai][1][m][0], u1 = acc[ai][1][m][1];
                if (SCALE) { const float rs = RS.get(u, row); g0 = g0 * rs; g1 = g1 * rs; u0 = u0 * rs; u1 = u1 * rs; }
                u32x4 w;
                w.x = cvt_pk_bf16(g0[0] * sigm(g0[0]) * u0[0], g0[1] * sigm(g0[1]) * u0[1]);
                w.y = cvt_pk_bf16(g0[2] * sigm(g0[2]) * u0[2], g0[3] * sigm(g0[3]) * u0[3]);
                w.z = cvt_pk_bf16(g1[0] * sigm(g1[0]) * u1[0], g1[1] * sigm(g1[1]) * u1[1]);
                w.w = cvt_pk_bf16(g1[2] * sigm(g1[2]) * u1[2], g1[3] * sigm(g1[3]) * u1[3]);
                __builtin_nontemporal_store(w, (u32x4*)p);
            }
    }
};
template <bool BASE_F32> struct EpiResidB {
    static constexpr bool PERM = true, AFTER_DRAIN = false, PAIRED = false;
    const void* base; bf16_t* X; float alpha; float* SS;
    __device__ __forceinline__ void operator()(const f32x4 (&acc)[2][2][4][2], const Unit& u, int wr, int wc, int fr, int fq) const {
        const int row0 = u.pm * BM + wr * 64 + fr, col0 = u.pn * BM + wc * 32 + 8 * fq;
#pragma unroll
        for (int ai = 0; ai < 2; ++ai) {
            f32x4 b0[4][2], b1[4][2];
            if (BASE_F32) {
#pragma unroll
                for (int m = 0; m < 4; ++m)
#pragma unroll
                    for (int bj = 0; bj < 2; ++bj) { const float* p = (const float*)base + (size_t)(row0 + ai * HALF + m * 16) * 1024 + col0 + bj * HALF; b0[m][bj] = __builtin_nontemporal_load((const f32x4*)p); b1[m][bj] = __builtin_nontemporal_load((const f32x4*)(p + 4)); }
            } else {
                u32x4 t[4][2];
#pragma unroll
                for (int m = 0; m < 4; ++m)
#pragma unroll
                    for (int bj = 0; bj < 2; ++bj) t[m][bj] = *(const u32x4*)((const bf16_t*)base + tix((size_t)(row0 + ai * HALF + m * 16), col0 + bj * HALF, 16, XN_TILED));
                __builtin_amdgcn_sched_barrier(0);
#pragma unroll
                for (int m = 0; m < 4; ++m)
#pragma unroll
                    for (int bj = 0; bj < 2; ++bj) { const u32x4 w = t[m][bj]; b0[m][bj] = (f32x4){bf_lo(w.x), bf_hi(w.x), bf_lo(w.y), bf_hi(w.y)}; b1[m][bj] = (f32x4){bf_lo(w.z), bf_hi(w.z), bf_lo(w.w), bf_hi(w.w)}; }
            }
            __builtin_amdgcn_sched_barrier(0);
#pragma unroll
            for (int m = 0; m < 4; ++m) {
                const size_t row = (size_t)(row0 + ai * HALF + m * 16);
                float ss = 0.f;
#pragma unroll
                for (int bj = 0; bj < 2; ++bj) {
                    const f32x4 v0 = b0[m][bj] + acc[ai][bj][m][0] * alpha, v1 = b1[m][bj] + acc[ai][bj][m][1] * alpha;
                    ss += ((v0[0] * v0[0] + v0[1] * v0[1]) + (v0[2] * v0[2] + v0[3] * v0[3])) + ((v1[0] * v1[0] + v1[1] * v1[1]) + (v1[2] * v1[2] + v1[3] * v1[3]));
                    u32x4 w; w.x = cvt_pk_bf16(v0[0], v0[1]); w.y = cvt_pk_bf16(v0[2], v0[3]); w.z = cvt_pk_bf16(v1[0], v1[1]); w.w = cvt_pk_bf16(v1[2], v1[3]);
                    *(u32x4*)(X + tix(row, col0 + bj * HALF, 16, XN_TILED)) = w;
                }
                ss += __shfl_xor(ss, 16); ss += __shfl_xor(ss, 32);
                if (fq == 0) SS[row * 16 + u.pn * 4 + wc] = ss;
            }
        }
    }
};
struct EpiProjIn {
    static constexpr bool PERM = true, AFTER_DRAIN = false, PAIRED = false;
    bf16_t* P; bf16_t* GT; RowScale RS;
    __device__ __forceinline__ void operator()(const f32x4 (&acc)[2][2][4][2], const Unit& u, int wr, int wc, int fr, int fq) const {
        const int row0 = u.pm * BM + wr * 64 + fr;
        const int kind = (u.pn < 2 || u.pn == 6 || u.pn == 7) ? 1 : (u.pn >= 9 ? 2 : 0);
#pragma unroll
        for (int ai = 0; ai < 2; ++ai)
#pragma unroll
            for (int m = 0; m < 4; ++m) {
                const size_t row = (size_t)(row0 + ai * HALF + m * 16);
                const float rs = RS.get(u, row);
                if (kind == 2) {
                    const int gp = u.pn - 9;
                    bf16_t* p = GT + gidx(0, u.pm, gp >> 1, (int)(row & 255), (gp & 1) * HALF + wc * 32 + 8 * fq);
                    float rr[8], sb[8];
#pragma unroll
                    for (int n = 0; n < 2; ++n)
#pragma unroll
                        for (int j = 0; j < 4; ++j) {
                            const float ga = __builtin_fmaxf(acc[ai][0][m][n][j] * rs, -30.f), gb = __builtin_fmaxf(acc[ai][1][m][n][j] * rs, -30.f);
                            const float ea = __builtin_amdgcn_exp2f(-1.4426950408889634f * ga), eb = __builtin_amdgcn_exp2f(-1.4426950408889634f * gb);
                            rr[n * 4 + j] = (1.0f + eb) * __builtin_amdgcn_rcpf(1.0f + ea); sb[n * 4 + j] = __builtin_amdgcn_rcpf(1.0f + eb);
                        }
                    u32x4 w; w.x = cvt_pk_bf16(rr[0], rr[1]); w.y = cvt_pk_bf16(rr[2], rr[3]); w.z = cvt_pk_bf16(rr[4], rr[5]); w.w = cvt_pk_bf16(rr[6], rr[7]);
                    __builtin_nontemporal_store(w, (u32x4*)p);
                    w.x = cvt_pk_bf16(sb[0], sb[1]); w.y = cvt_pk_bf16(sb[2], sb[3]); w.z = cvt_pk_bf16(sb[4], sb[5]); w.w = cvt_pk_bf16(sb[6], sb[7]);
                    __builtin_nontemporal_store(w, (u32x4*)(p + gidx(1, 0, 0, 0, 0)));
                } else {
                    bf16_t* p = P + row * PROJ_LD + u.pn * BM + wc * 32 + 8 * fq;
                    const float sc = kind == 1 ? rs * QSCALE : rs;
#pragma unroll
                    for (int bj = 0; bj < 2; ++bj) {
                        const f32x4 v0 = acc[ai][bj][m][0] * sc, v1 = acc[ai][bj][m][1] * sc;
                        u32x4 w; w.x = cvt_pk_bf16(v0[0], v0[1]); w.y = cvt_pk_bf16(v0[2], v0[3]); w.z = cvt_pk_bf16(v1[0], v1[1]); w.w = cvt_pk_bf16(v1[2], v1[3]);
                        *(u32x4*)(p + bj * HALF) = w;
                    }
                }
            }
    }
};
struct PairOrder {
    StaticOrder base;
    __host__ __device__ void init(int M, int N, int G_, int c_) { base.init(M, N, G_, c_); }
    __host__ __device__ bool next(int i, Unit& u) const { Unit b; if (!base.next(i >> 1, b)) return false; u.pm = b.pm + (i & 1) * base.nM; u.pn = b.pn + (i & 1) * base.nN; return true; }
    __device__ __forceinline__ void a_ready(const Unit&) const {}
    __device__ __forceinline__ void done(const Unit&) const {}
};
struct EpiGatePair {
    static constexpr bool PERM = true, AFTER_DRAIN = false, PAIRED = true;
    const bf16_t* P; bf16_t* T;
    __device__ __forceinline__ void operator()(f32x4 (&acc)[2][2][4][2], const Unit& u, int wr, int wc, int fr, int fq) const {
        const int stage = u.pm >= 128 ? 1 : 0, pm = u.pm & 127, pn = u.pn & 3;
        const int row0 = pm * BM + wr * 64 + fr, col0 = pn * BM + wc * 32 + 8 * fq;
        u32x4 gt[2][4][2];
#pragma unroll
        for (int ai = 0; ai < 2; ++ai)
#pragma unroll
            for (int m = 0; m < 4; ++m)
#pragma unroll
                for (int bj = 0; bj < 2; ++bj) gt[ai][m][bj] = *(const u32x4*)(P + gidx(stage, pm, pn, wr * 64 + fr + ai * HALF + m * 16, wc * 32 + 8 * fq + bj * HALF));
        __builtin_amdgcn_sched_barrier(0);
#pragma unroll
        for (int ai = 0; ai < 2; ++ai)
#pragma unroll
            for (int m = 0; m < 4; ++m) {
                const size_t row = (size_t)(row0 + ai * HALF + m * 16);
#pragma unroll
                for (int bj = 0; bj < 2; ++bj) {
                    const int c = col0 + bj * HALF;
                    const u32x4 g = gt[ai][m][bj];
                    f32x4 v0 = acc[ai][bj][m][0], v1 = acc[ai][bj][m][1];
                    v0[0] *= bf_lo(g.x); v0[1] *= bf_hi(g.x); v0[2] *= bf_lo(g.y); v0[3] *= bf_hi(g.y);
                    v1[0] *= bf_lo(g.z); v1[1] *= bf_hi(g.z); v1[2] *= bf_lo(g.w); v1[3] *= bf_hi(g.w);
                    if (stage == 0) { acc[ai][bj][m][0] = v0; acc[ai][bj][m][1] = v1; }
                    else { u32x4 w; w.x = cvt_pk_bf16(v0[0], v0[1]); w.y = cvt_pk_bf16(v0[2], v0[3]); w.z = cvt_pk_bf16(v1[0], v1[1]); w.w = cvt_pk_bf16(v1[2], v1[3]);
                           *(u32x4*)(T + tix(row, c, 16, T_TILED)) = w; }
                }
            }
    }
};
template <class Epi, class Sched, bool ALIGN_EPI = false, bool SP2 = false, bool NTA = false  >
__device__ __forceinline__ void gemm_phase(PG8_LAS unsigned char* lds, const Gemm g, const Sched& S, const Epi& E) {
    int tid_ = threadIdx.x; asm volatile("" : "+v"(tid_));
    const int tid = tid_, wid = __builtin_amdgcn_readfirstlane(tid >> 6), lane = tid & 63, wr = wid >> 2, wc = wid & 3, fr = lane & 15, fq = lane >> 4;
    const int K = g.K, nt = K / BK;
    unsigned voffA[2], voffB[2];
#pragma unroll
    for (int i = 0; i < 2; ++i) { int R, C; stage_rc(tid * 16 + i * 8192, R, C); const int Rb = Epi::PERM ? ((R & ~31) + perm32(R & 31)) : R;
        voffA[i] = g.tiledA ? (unsigned)(R * BK + C) * 2u : (unsigned)(R * K + C) * 2u; voffB[i] = g.tiledB ? (unsigned)(Rb * BK + C) * 2u : (unsigned)(Rb * K + C) * 2u; }
    const size_t kstep = (size_t)(BK * 2);
    const size_t hstep = (size_t)HALF * K * 2;
    const size_t tstep = 2 * hstep;
    const size_t kstepA = g.tiledA ? (size_t)(BM * BK * 2) : kstep, hstepA = g.tiledA ? (size_t)(HALF * BK * 2) : hstep, tstepA = g.tiledA ? (size_t)nt * (BM * BK * 2) : tstep;
    const size_t kstepB = g.tiledB ? (size_t)(BM * BK * 2) : kstep, hstepB = g.tiledB ? (size_t)(HALF * BK * 2) : hstep, tstepB = g.tiledB ? (size_t)nt * (BM * BK * 2) : tstep;
    const unsigned ldsw = (unsigned)wid * 1024u;
    const int aoff = lds_byte(wr * 64 + fr, fq * 8), boff = lds_byte(wc * 32 + fr, fq * 8);
#define PG8_SA(b, h) (((b) * 2 + (h)) * HTB)
#define PG8_SB(b, h) ((4 + (b) * 2 + (h)) * HTB)
#define PG8_STAGE(bufoff, gbase, voff) do { _Pragma("unroll") for (int _i = 0; _i < 2; ++_i) \
        __builtin_amdgcn_global_load_lds((const unsigned*)((const char*)(gbase) + (voff)[_i]), (PG8_LAS unsigned*)(lds + (bufoff) + ldsw + _i * 8192), 16, 0, 0); } while (0)
#define PG8_STAGEA(bufoff, gbase, voff) do { _Pragma("unroll") for (int _i = 0; _i < 2; ++_i) { \
        if constexpr (NTA) __builtin_amdgcn_global_load_lds((const unsigned*)((const char*)(gbase) + (voff)[_i]), (PG8_LAS unsigned*)(lds + (bufoff) + ldsw + _i * 8192), 16, 0, 2); \
        else __builtin_amdgcn_global_load_lds((const unsigned*)((const char*)(gbase) + (voff)[_i]), (PG8_LAS unsigned*)(lds + (bufoff) + ldsw + _i * 8192), 16, 0, 0); } } while (0)
#define PG8_LDA(dst, b, h) do { _Pragma("unroll") for (int m = 0; m < 4; ++m) _Pragma("unroll") for (int k = 0; k < 2; ++k) dst[m][k] = *(const PG8_LAS bf16x8*)(lds + PG8_SA(b, h) + aoff + m * 2048 + k * 1024); } while (0)
#define PG8_LDB(dst, b, h) do { _Pragma("unroll") for (int n = 0; n < 2; ++n) _Pragma("unroll") for (int k = 0; k < 2; ++k) dst[n][k] = *(const PG8_LAS bf16x8*)(lds + PG8_SB(b, h) + boff + n * 2048 + k * 1024); } while (0)
#define PG8_MMA(ai, bj, At, Bt) do { __builtin_amdgcn_s_setprio(1); _Pragma("unroll") for (int m = 0; m < 4; ++m) _Pragma("unroll") for (int n = 0; n < 2; ++n) _Pragma("unroll") for (int k = 0; k < 2; ++k) \
        acc[ai][bj][m][n] = __builtin_amdgcn_mfma_f32_16x16x32_bf16(Bt[n][k], At[m][k], acc[ai][bj][m][n], 0, 0, 0); __builtin_amdgcn_s_setprio(0); } while (0)
#define PG8_WAIT_V(n) asm volatile("s_waitcnt vmcnt(" #n ")" ::: "memory")
#define PG8_WAIT_L(n) asm volatile("s_waitcnt lgkmcnt(" #n ")" ::: "memory")
#define PG8_BAR __builtin_amdgcn_s_barrier()
#define PG8_SCHED __builtin_amdgcn_sched_barrier(0)
    Unit cur, nxt; int ui = 0;
    if (!S.next(0, cur)) return;
    f32x4 acc[2][2][4][2];
#pragma unroll
    for (int a = 0; a < 2; ++a)
#pragma unroll
        for (int b = 0; b < 2; ++b)
#pragma unroll
            for (int m = 0; m < 4; ++m)
#pragma unroll
                for (int n = 0; n < 2; ++n) acc[a][b][m][n] = (f32x4){0.f, 0.f, 0.f, 0.f};
    bf16x8 At[4][2], B0[2][2], B1[2][2];
    const char* cA = (const char*)g.A + (size_t)cur.pm * tstepA; const char* cB = (const char*)g.Bt + (size_t)cur.pn * tstepB;
    S.a_ready(cur);
    if constexpr (SP2) {
        PG8_STAGE(PG8_SB(0, 0), cB, voffB); PG8_STAGE(PG8_SB(0, 1), cB + hstepB, voffB); PG8_STAGEA(PG8_SA(0, 0), cA, voffA); PG8_STAGEA(PG8_SA(0, 1), cA + hstepA, voffA);
        if (wr == 1) PG8_BAR;
        PG8_WAIT_V(2); PG8_BAR;
        PG8_STAGE(PG8_SB(1, 0), cB + kstepB, voffB); PG8_STAGEA(PG8_SA(1, 0), cA + kstepA, voffA); PG8_STAGE(PG8_SB(1, 1), cB + hstepB + kstepB, voffB);
        PG8_WAIT_V(6); PG8_BAR;
    } else {
        PG8_STAGE(PG8_SB(0, 0), cB, voffB); PG8_STAGEA(PG8_SA(0, 0), cA, voffA); PG8_STAGE(PG8_SB(0, 1), cB + hstepB, voffB); PG8_STAGEA(PG8_SA(0, 1), cA + hstepA, voffA);
        if (wr == 1) PG8_BAR;
        PG8_WAIT_V(4); PG8_BAR;
        PG8_STAGE(PG8_SB(1, 0), cB + kstepB, voffB); PG8_STAGEA(PG8_SA(1, 0), cA + kstepA, voffA); PG8_STAGE(PG8_SB(1, 1), cB + hstepB + kstepB, voffB);
        PG8_WAIT_V(6); PG8_BAR;
    }
    for (;;) {
        const bool has_next = S.next(ui + 1, nxt);
        const char* nA = has_next ? (const char*)g.A + (size_t)nxt.pm * tstepA : cA; const char* nB = has_next ? (const char*)g.Bt + (size_t)nxt.pn * tstepB : cB;
        for (int t = 0; t < nt; t += 2) {
            const bool last = (t == nt - 2);
            const char* a1 = cA + (size_t)(t + 1) * kstepA;
            const char* a2 = last ? nA : cA + (size_t)(t + 2) * kstepA; const char* b2 = last ? nB : cB + (size_t)(t + 2) * kstepB;
            const char* a3 = a2 + kstepA; const char* b3 = b2 + kstepB;
            if (last && has_next) S.a_ready(nxt);
            if constexpr (SP2) {
            PG8_LDB(B0, 0, 0); PG8_LDB(B1, 0, 1); PG8_SCHED; PG8_LDA(At, 0, 0); PG8_STAGEA(PG8_SA(1, 1), a1 + hstepA, voffA);
            PG8_WAIT_V(8); PG8_WAIT_L(0); PG8_BAR; PG8_MMA(0, 0, At, B0); PG8_MMA(0, 1, At, B1); PG8_BAR; PG8_SCHED;
            PG8_LDA(At, 0, 1); PG8_STAGE(PG8_SB(0, 0), b2, voffB); PG8_STAGE(PG8_SB(0, 1), b2 + hstepB, voffB); PG8_STAGEA(PG8_SA(0, 0), a2, voffA);
            PG8_WAIT_V(8); PG8_WAIT_L(0); PG8_BAR; PG8_MMA(1, 0, At, B0); PG8_MMA(1, 1, At, B1); PG8_BAR; PG8_SCHED;
            PG8_LDB(B0, 1, 0); PG8_LDB(B1, 1, 1); PG8_SCHED; PG8_LDA(At, 1, 0); PG8_STAGEA(PG8_SA(0, 1), a2 + hstepA, voffA);
            PG8_WAIT_V(8); PG8_WAIT_L(0); PG8_BAR; PG8_MMA(0, 0, At, B0); PG8_MMA(0, 1, At, B1); PG8_BAR; PG8_SCHED;
            PG8_LDA(At, 1, 1); PG8_STAGE(PG8_SB(1, 0), b3, voffB); PG8_STAGE(PG8_SB(1, 1), b3 + hstepB, voffB); PG8_STAGEA(PG8_SA(1, 0), a3, voffA);
            PG8_WAIT_V(8); PG8_WAIT_L(0); PG8_BAR; PG8_MMA(1, 0, At, B0); PG8_MMA(1, 1, At, B1); PG8_BAR; PG8_SCHED;
            } else {
            PG8_LDB(B0, 0, 0); PG8_SCHED; PG8_LDA(At, 0, 0); PG8_STAGEA(PG8_SA(1, 1), a1 + hstepA, voffA);
            PG8_WAIT_L(8); PG8_BAR; PG8_WAIT_L(0); PG8_MMA(0, 0, At, B0); PG8_BAR; PG8_SCHED;
            PG8_LDB(B1, 0, 1); PG8_STAGE(PG8_SB(0, 0), b2, voffB);
            PG8_BAR; PG8_WAIT_L(0); PG8_MMA(0, 1, At, B1); PG8_BAR;
            PG8_LDA(At, 0, 1); PG8_STAGEA(PG8_SA(0, 0), a2, voffA);
            PG8_BAR; PG8_WAIT_L(0); PG8_MMA(1, 0, At, B0); PG8_BAR; PG8_SCHED;
            PG8_STAGE(PG8_SB(0, 1), b2 + hstepB, voffB);
            PG8_WAIT_V(6); PG8_BAR; PG8_MMA(1, 1, At, B1); PG8_BAR;
            PG8_LDB(B0, 1, 0); PG8_SCHED; PG8_LDA(At, 1, 0); PG8_STAGEA(PG8_SA(0, 1), a2 + hstepA, voffA);
            PG8_WAIT_L(8); PG8_BAR; PG8_WAIT_L(0); PG8_MMA(0, 0, At, B0); PG8_BAR; PG8_SCHED;
            PG8_LDB(B1, 1, 1); PG8_STAGE(PG8_SB(1, 0), b3, voffB);
            PG8_BAR; PG8_WAIT_L(0); PG8_MMA(0, 1, At, B1); PG8_BAR;
            PG8_LDA(At, 1, 1); PG8_STAGEA(PG8_SA(1, 0), a3, voffA);
            PG8_BAR; PG8_WAIT_L(0); PG8_MMA(1, 0, At, B0); PG8_BAR; PG8_SCHED;
            PG8_STAGE(PG8_SB(1, 1), b3 + hstepB, voffB);
            PG8_WAIT_V(6); PG8_BAR; PG8_MMA(1, 1, At, B1); PG8_BAR;
            }
        }
        if constexpr (ALIGN_EPI) { if (wr == 0) PG8_BAR; }
        if constexpr (!Epi::AFTER_DRAIN) { E(acc, cur, wr, wc, fr, fq); S.done(cur); }
        if (!has_next) break;
        if (!(Epi::PAIRED && (ui & 1) == 0)) {
#pragma unroll
        for (int a = 0; a < 2; ++a)
#pragma unroll
            for (int b = 0; b < 2; ++b)
#pragma unroll
                for (int m = 0; m < 4; ++m)
#pragma unroll
                    for (int n = 0; n < 2; ++n) acc[a][b][m][n] = (f32x4){0.f, 0.f, 0.f, 0.f};
        }
        cur = nxt; cA = nA; cB = nB; ++ui;
        if constexpr (ALIGN_EPI) { if (wr == 1) PG8_BAR; }
    }
    PG8_WAIT_V(0);
    if constexpr (!ALIGN_EPI) { if (wr == 0) PG8_BAR; }
    PG8_BAR;
    if constexpr (Epi::AFTER_DRAIN) { E.fused(acc, cur, wr, wc, fr, fq, lds, wid, lane); S.done(cur); }
#undef PG8_SA
#undef PG8_SB
#undef PG8_STAGE
#undef PG8_STAGEA
#undef PG8_LDA
#undef PG8_LDB
#undef PG8_MMA
#undef PG8_WAIT_V
#undef PG8_WAIT_L
#undef PG8_BAR
#undef PG8_SCHED
}
}
#define LAS __attribute__((address_space(3)))
typedef unsigned short bf16_t;
typedef short bf16x8 __attribute__((ext_vector_type(8)));
typedef short s16x4 __attribute__((ext_vector_type(4)));
typedef float f32x4 __attribute__((ext_vector_type(4)));
typedef float f32x16 __attribute__((ext_vector_type(16)));
typedef unsigned u32x4 __attribute__((ext_vector_type(4)));
typedef unsigned u32x2 __attribute__((ext_vector_type(2)));

constexpr int NB = 16, SEQ = 2048, DM = 1024, FF = 2816, NIN = 4352, M = NB * SEQ;
constexpr int NWAVES = 8;
constexpr float EPS = 1e-6f, LOG2E = 1.4426950408889634f;
constexpr size_t MiB = 1u << 20;
constexpr size_t WS_WF1 = 1 * MiB, WS_WD1 = 12 * MiB, WS_WIN = 18 * MiB, WS_WPA = 27 * MiB, WS_WPB = 28 * MiB, WS_WOUT = 29 * MiB, WS_WF2 = 31 * MiB, WS_WD2 = 42 * MiB;
constexpr size_t WS_XN = 48 * MiB, WS_BIG = 112 * MiB, WS_OA = 384 * MiB, WS_OB = 416 * MiB, WS_SS1 = 448 * MiB, WS_SS2 = 450 * MiB, WS_END = 452 * MiB;
static_assert(WS_WD2 + (size_t)DM * FF * 2 <= WS_XN && WS_BIG + (size_t)M * NIN * 2 <= WS_OA, "d_ws map");
constexpr int RING_BYTES = 131072, LDS_BYTES = 147456, MISC_OFF = RING_BYTES + 256;
constexpr size_t WS_BAR = 0, BAR_ZERO_BYTES = 16384;

__device__ __forceinline__ float wave_sum(float v) {
#pragma unroll
    for (int o = 1; o < 64; o <<= 1) v += __shfl_xor(v, o);
    return v;
}
__device__ __forceinline__ unsigned f2bf(float f) { unsigned u = __builtin_bit_cast(unsigned, f); return (u + 0x7fffu + ((u >> 16) & 1u)) >> 16; }
__device__ __forceinline__ unsigned pk2(float lo, float hi) { return f2bf(lo) | (f2bf(hi) << 16); }

#define XB_TMO      128
#define XB_XCNT(j)  (256  + 64 * (j))
#define XB_XSUB(j)  (1280 + 64 * (j))
#define XB_XGEN(j)  (2304 + 64 * (j))
#define XB_TOP      3328
#define XB_TOPGEN   3392
#define XCD_BAR_WORDS 3456
#define XB_SPIN_CAP (1u << 18)

__device__ __forceinline__ unsigned xb_ld(unsigned* p)              { return __hip_atomic_load(p, __ATOMIC_RELAXED, __HIP_MEMORY_SCOPE_AGENT); }
__device__ __forceinline__ unsigned xb_add(unsigned* p, unsigned v) { return __hip_atomic_fetch_add(p, v, __ATOMIC_RELAXED, __HIP_MEMORY_SCOPE_AGENT); }
__device__ __forceinline__ unsigned xb_xcc_id() { return (unsigned)__builtin_amdgcn_s_getreg((3 << 11) | 20) & 0xFu; }
#define XB_SPIN(cond, bar) do { unsigned _sp = 0; while (cond) { __builtin_amdgcn_s_sleep(1); \
    if ((++_sp & 255u) == 0u) { if (xb_ld(&(bar)[XB_TMO])) break; if (_sp > XB_SPIN_CAP) { atomicAdd(&(bar)[XB_TMO], 1u); break; } } } } while (0)

struct XcdBarrier {
    unsigned* bar; unsigned x;
    volatile LAS unsigned* st;
};

__device__ __forceinline__ XcdBarrier xcd_barrier_post(unsigned* bar, volatile LAS unsigned* st) {
    XcdBarrier b; b.bar = bar; b.x = xb_xcc_id(); b.st = st;
    if (threadIdx.x == 0) (void)xb_add(&bar[XB_XCNT(b.x)], 1u);
    return b;
}
__device__ __forceinline__ void xcd_barrier_complete(unsigned* bar, unsigned x, unsigned& nloc, unsigned& nx) {
    const unsigned G = gridDim.x * gridDim.y * gridDim.z;
    unsigned sum, cnt, mine, sp = 0u;
    for (;;) {
        sum = 0u; cnt = 0u; mine = 0u;
#pragma unroll
        for (unsigned j = 0; j < 16; ++j) { const unsigned c = xb_ld(&bar[XB_XCNT(j)]); sum += c; cnt += (c > 0u) ? 1u : 0u; mine = (j == x) ? c : mine; }
        if (sum == G) break;
        __builtin_amdgcn_s_sleep(1);
        if ((++sp & 255u) == 0u) { if (xb_ld(&bar[XB_TMO])) break; if (sp > XB_SPIN_CAP) { atomicAdd(&bar[XB_TMO], 1u); break; } }
    }
    nloc = mine > 0u ? mine : 1u; nx = cnt > 0u ? cnt : 1u;
}

__device__ __forceinline__ void xcd_barrier(const XcdBarrier& b) {
    asm volatile("s_waitcnt vmcnt(0)" ::: "memory");
    __syncthreads();
    if (threadIdx.x == 0) {
        unsigned* bar = b.bar;
        __builtin_amdgcn_s_waitcnt(0);
        unsigned nloc = b.st[0], nx = b.st[1];
        if (nloc == 0u) { xcd_barrier_complete(bar, b.x, nloc, nx); b.st[0] = nloc; b.st[1] = nx; }
        const unsigned old = xb_add(&bar[XB_XSUB(b.x)], 1u);
        const unsigned gen = old / nloc;
        if (old + 1u == (gen + 1u) * nloc) {
            __builtin_amdgcn_fence(__ATOMIC_RELEASE, "agent");
            asm volatile("s_waitcnt vmcnt(0)" ::: "memory");
            const unsigned og = xb_add(&bar[XB_TOP], 1u);
            const unsigned tg = og / nx;
            if (og + 1u == (tg + 1u) * nx) xb_add(&bar[XB_TOPGEN], 1u);
            else XB_SPIN(xb_ld(&bar[XB_TOPGEN]) == tg, bar);
            __builtin_amdgcn_fence(__ATOMIC_ACQUIRE, "agent");
            xb_add(&bar[XB_XGEN(b.x)], 1u);
            asm volatile("s_waitcnt vmcnt(0)" ::: "memory");
        } else {
            XB_SPIN(xb_ld(&bar[XB_XGEN(b.x)]) == gen, bar);
            __builtin_amdgcn_fence(__ATOMIC_ACQUIRE, "agent");
            asm volatile("s_waitcnt vmcnt(0)" ::: "memory");
        }
    }
    __syncthreads();
}

__device__ __forceinline__ void transpose_item(const float* W, int K, int N, bf16_t* WT, int ilv, const float* gain, LAS float* scr, int item, int lane) {
    const int nblk = N / 32, kb = item / nblk, nb = item % nblk, k0 = 64 * kb, n0 = 32 * nb;
    int rbase = n0; const int il = ilv & 7;
    if (il == 1 || il == 2) rbase = (n0 >> 7) * 256 + (n0 & 127) + (il == 2 ? 128 : 0);
    else if (il == 3 && n0 >= 2304) { const int jg = (n0 - 2304) & 1023; rbase = 2304 + (jg >> 7) * 256 + (jg & 127) + (n0 >= 3328 ? 128 : 0); }
#pragma unroll
    for (int i = 0; i < 32; ++i) { const int kk = 2 * i + (lane >> 5); const float gk = gain ? gain[k0 + kk] : 1.0f; scr[kk * 33 + (lane & 31)] = W[(size_t)(k0 + kk) * N + n0 + (lane & 31)] * gk; }
    asm volatile("s_waitcnt lgkmcnt(0)" ::: "memory");
    const int c = lane & 7;
#pragma unroll
    for (int j = 0; j < 4; ++j) { const int n = (lane >> 3) + 8 * j; const LAS float* s = scr + (8 * c) * 33 + n;
        u32x4 o; o.x = pk2(s[0 * 33], s[1 * 33]); o.y = pk2(s[2 * 33], s[3 * 33]); o.z = pk2(s[4 * 33], s[5 * 33]); o.w = pk2(s[6 * 33], s[7 * 33]);
        const int rown = rbase + n;
        bf16_t* dst = (ilv & 8) ? WT + ((size_t)((rown >> 8) * (K >> 6) + (k0 >> 6)) * 256 + (rown & 255)) * 64 + 8 * c : WT + (size_t)rown * K + k0 + 8 * c;
        *(u32x4*)dst = o; }
    asm volatile("s_waitcnt lgkmcnt(0)" ::: "memory");
}
__device__ __forceinline__ void rms_rows2_bf16(const float* xrow, bf16_t* XNb, size_t row, int lane) {
    const f32x4* xr = (const f32x4*)xrow + lane;
    f32x4 v[2][4]; float s[2] = {0.f, 0.f};
#pragma unroll
    for (int q = 0; q < 2; ++q)
#pragma unroll
        for (int j = 0; j < 4; ++j) v[q][j] = __builtin_nontemporal_load(xr + q * 256 + 64 * j);
#pragma unroll
    for (int q = 0; q < 2; ++q)
#pragma unroll
        for (int j = 0; j < 4; ++j) s[q] += (v[q][j].x * v[q][j].x + v[q][j].y * v[q][j].y) + (v[q][j].z * v[q][j].z + v[q][j].w * v[q][j].w);
#pragma unroll
    for (int q = 0; q < 2; ++q) {
        const float rstd = 1.0f / sqrtf(wave_sum(s[q]) * (1.0f / DM) + EPS);
#pragma unroll
        for (int j = 0; j < 4; ++j) { u32x2 w; w.x = pk2(v[q][j].x * rstd, v[q][j].y * rstd); w.y = pk2(v[q][j].z * rstd, v[q][j].w * rstd);
            *(u32x2*)(XNb + pg8::tix(row + q, 4 * lane + 256 * j, 16, XN_TILED)) = w; }
    }
}
__device__ __forceinline__ float bfl(unsigned w) { return __uint_as_float(w << 16); }
__device__ __forceinline__ float bfh(unsigned w) { return __uint_as_float(w & 0xffff0000u); }
__device__ __forceinline__ void final_rows2(const bf16_t* XNb, const float* SS, size_t row, const float* g, float* orow, int lane) {
    u32x4 t[2][2];
#pragma unroll
    for (int q = 0; q < 2; ++q)
#pragma unroll
        for (int hf = 0; hf < 2; ++hf) t[q][hf] = *(const u32x4*)(XNb + pg8::tix(row + q, hf * 512 + 8 * lane, 16, XN_TILED));
    f32x4 gv[2][2];
#pragma unroll
    for (int hf = 0; hf < 2; ++hf) { gv[hf][0] = *(const f32x4*)(g + hf * 512 + 8 * lane); gv[hf][1] = *(const f32x4*)(g + hf * 512 + 8 * lane + 4); }
#pragma unroll
    for (int q = 0; q < 2; ++q) {
        const f32x4* p = (const f32x4*)(SS + (row + q) * 16);
        const f32x4 a = p[0], b2 = p[1], c = p[2], d = p[3];
        const float s = ((a[0] + a[1]) + (a[2] + a[3])) + ((b2[0] + b2[1]) + (b2[2] + b2[3])) + ((c[0] + c[1]) + (c[2] + c[3])) + ((d[0] + d[1]) + (d[2] + d[3]));
        const float rstd = 1.0f / sqrtf(s * (1.0f / DM) + EPS);
#pragma unroll
        for (int hf = 0; hf < 2; ++hf) {
            const u32x4 w = t[q][hf];
            const f32x4 v0 = (f32x4){bfl(w.x), bfh(w.x), bfl(w.y), bfh(w.y)}, v1 = (f32x4){bfl(w.z), bfh(w.z), bfl(w.w), bfh(w.w)};
            float* o = orow + q * 1024 + hf * 512 + 8 * lane;
            __builtin_nontemporal_store(v0 * rstd * gv[hf][0], (f32x4*)o); __builtin_nontemporal_store(v1 * rstd * gv[hf][1], (f32x4*)(o + 4));
        }
    }
}

__device__ __forceinline__ int crow(int r, int hi) { return (r & 3) + 8 * (r >> 2) + 4 * hi; }
typedef float f32x2_t __attribute__((ext_vector_type(2))); typedef __bf16 bf16x2_t __attribute__((ext_vector_type(2)));
__device__ __forceinline__ unsigned cvtpk(float lo, float hi) { f32x2_t v = {lo, hi}; bf16x2_t b = __builtin_convertvector(v, bf16x2_t); return __builtin_bit_cast(unsigned, b); }
constexpr int VT_PITCH = 72, TAB_OFF = 64 * VT_PITCH;

__device__ __forceinline__ float xmax32(float v) {
    auto rr = __builtin_amdgcn_permlane32_swap(__float_as_uint(v), __float_as_uint(v), false, false);
    return __builtin_fmaxf(__uint_as_float(rr[0]), __uint_as_float(rr[1]));
}
typedef short v4i16_t __attribute__((ext_vector_type(4)));
constexpr float RESC_THR = 8.0f;
constexpr int KS_PITCH = 144, ATT_VT = 64 * KS_PITCH, ATT_BUF = 2 * 64 * KS_PITCH, ATT_TAB = 2 * ATT_BUF;
__device__ __forceinline__ void attn_first_ptrs(const bf16_t* PROJ, bool isB, int b, int hx, int cx, int tid, int lane, int wave, const bf16_t*& kp, const bf16_t*& vp, const bf16_t*& qp) {
    const int nprev = isB ? 2 : 8, j0 = cx < nprev ? nprev - cx : 0;
    const long srow = (long)b * SEQ + (cx - nprev + j0) * 64 + (tid >> 3);
    const bf16_t* base = PROJ + (size_t)srow * pg8::PROJ_LD + 8 * (tid & 7);
    kp = base + (isB ? 2048 + hx * 64 : 512 + hx * 64); vp = base + (isB ? 2176 + hx * 64 : 1024 + hx * 64);
    const int h = isB ? 4 * hx + (wave >> 1) : hx, cq = isB ? cx : cx + (wave >> 1);
    qp = PROJ + ((size_t)b * SEQ + cq * 64 + (wave & 1) * 32 + (lane & 31)) * pg8::PROJ_LD + (isB ? 1536 : 0) + h * 64 + 8 * (lane >> 5);
}
struct AttnNext { bool valid, isB; int b, hx, cx; };
template <bool IS_B>
__device__ __forceinline__ void attn_wg_unit(const bf16_t* __restrict__ PROJ, bf16_t* __restrict__ Oout, int b, int hx, int cx, LAS unsigned char* lds,
                                             const float* __restrict__ rel_bias, const float* __restrict__ sinks, int tid, int lane, int wave,
                                             bf16x8& kreg, bf16x8& vreg, bf16x8 (&qf)[4], const AttnNext nx) {
    constexpr int NPREV = IS_B ? 2 : 8, PP = pg8::PROJ_LD, NT = IS_B ? 3 : 12;
    const int r = lane & 31, hi = lane >> 5;
    const int ci = IS_B ? 0 : (wave >> 1), qh = wave & 1;
    const int h = IS_B ? 4 * hx + (wave >> 1) : hx;
    const int cq = cx + ci;
    const int qcol = IS_B ? 1536 + h * 64 : h * 64;
    const int kcol = IS_B ? 2048 + hx * 64 : 512 + hx * 64;
    const int vcol = IS_B ? 2176 + hx * 64 : 1024 + hx * 64;
    const size_t tok0 = (size_t)b * SEQ;
    const int j0 = cx < NPREV ? NPREV - cx : 0;
    const int srow = tid >> 3, sch = tid & 7;
    const long srow0 = (long)tok0 + (cx - NPREV) * 64 + srow;
#define ATT_SRC(j, col) (PROJ + (size_t)(srow0 + (long)(j) * 64) * PP + 8 * sch + (col))
    bf16x8 qn[4];
    const bf16_t *nkp = nullptr, *nvp = nullptr, *nqp = nullptr;
    if (nx.valid) attn_first_ptrs(PROJ, nx.isB, nx.b, nx.hx, nx.cx, tid, lane, wave, nkp, nvp, nqp);
    const LAS float* tab = (const LAS float*)(lds + ATT_TAB) + (IS_B ? 0 : h * 192);
    float m, l, slope2 = 0.f;
    if (IS_B) { m = ((const LAS float*)(lds + ATT_TAB))[8 * 192 + h]; l = hi == 0 ? 1.f : 0.f; slope2 = LOG2E * __builtin_amdgcn_exp2f(-(float)(h + 1)); }
    else { m = -1e30f; l = 0.f; }
    f32x16 o[2];
#pragma unroll
    for (int d = 0; d < 2; ++d)
#pragma unroll
        for (int i = 0; i < 16; ++i) o[d][i] = 0.f;
    for (int j = j0; j < NT; ++j) {
        LAS unsigned char* buf = lds + (j & 1) * ATT_BUF;
        *(LAS bf16x8*)(buf + srow * KS_PITCH + sch * 16) = kreg;
        *(LAS bf16x8*)(buf + ATT_VT + srow * KS_PITCH + sch * 16) = vreg;
        if (j + 1 < NT) { kreg = *(const bf16x8*)ATT_SRC(j + 1, kcol); vreg = *(const bf16x8*)ATT_SRC(j + 1, vcol); }
        else if (nx.valid) {
            kreg = *(const bf16x8*)nkp; vreg = *(const bf16x8*)nvp;
#pragma unroll
            for (int s = 0; s < 4; ++s) qn[s] = *(const bf16x8*)(nqp + 16 * s);
        }
        asm volatile("s_waitcnt lgkmcnt(0)" ::: "memory"); __builtin_amdgcn_s_barrier(); asm volatile("" ::: "memory");
        const int dc = IS_B ? NPREV - j : ci + NPREV - j;
        if (IS_B || (dc >= 0 && dc <= NPREV)) {
            f32x16 sv[2];
#pragma unroll
            for (int kh = 0; kh < 2; ++kh) {
#pragma unroll
                for (int i = 0; i < 16; ++i) sv[kh][i] = 0.f;
#pragma unroll
                for (int st = 0; st < 4; ++st) {
                    const bf16x8 kfr = *(const LAS bf16x8*)(buf + (32 * kh + r) * KS_PITCH + (16 * st + 8 * hi) * 2);
                    sv[kh] = __builtin_amdgcn_mfma_f32_32x32x16_bf16(kfr, qf[st], sv[kh], 0, 0, 0);
                }
            }
            const bool cbias = !IS_B && dc >= 3;
            const float cb = cbias ? tab[191] : 0.f;
            const int relq = 64 * dc + 32 * qh + r - 4 * hi;
            if (IS_B) {
                const float rf = (float)relq;
#pragma unroll
                for (int kh = 0; kh < 2; ++kh)
#pragma unroll
                    for (int i = 0; i < 16; ++i) sv[kh][i] -= slope2 * __builtin_fabsf(rf - (float)(32 * kh + (i & 3) + 8 * (i >> 2)));
            } else if (!cbias) {
#pragma unroll
                for (int kh = 0; kh < 2; ++kh)
#pragma unroll
                    for (int i = 0; i < 16; ++i) { int rel = relq - (32 * kh + (i & 3) + 8 * (i >> 2)); rel = rel > 128 ? 128 : rel; sv[kh][i] += tab[rel + 63]; }
            }
            float t0 = sv[0][0], t1 = sv[1][0];
#pragma unroll
            for (int i = 1; i < 16; i += 3) { t0 = __builtin_fmaxf(__builtin_fmaxf(t0, sv[0][i]), sv[0][i + 1]); t0 = __builtin_fmaxf(t0, sv[0][i + 2]); t1 = __builtin_fmaxf(__builtin_fmaxf(t1, sv[1][i]), sv[1][i + 1]); t1 = __builtin_fmaxf(t1, sv[1][i + 2]); }
            const float tm = xmax32(__builtin_fmaxf(t0, t1)) + cb;
            if (__any(tm > m + RESC_THR)) {
                const float mn = __builtin_fmaxf(m, tm);
                const float alpha = __builtin_amdgcn_exp2f(m - mn);
                m = mn; l *= alpha;
#pragma unroll
                for (int d = 0; d < 2; ++d)
#pragma unroll
                    for (int i = 0; i < 16; ++i) o[d][i] *= alpha;
            }
            const float off = m - cb;
            float ps0 = 0.f, ps1 = 0.f;
#pragma unroll
            for (int i = 0; i < 16; ++i) { sv[0][i] = __builtin_amdgcn_exp2f(sv[0][i] - off); sv[1][i] = __builtin_amdgcn_exp2f(sv[1][i] - off); ps0 += sv[0][i]; ps1 += sv[1][i]; }
            l += ps0 + ps1;
            bf16x8 pk[4];
#pragma unroll
            for (int ks = 0; ks < 4; ++ks) {
                const f32x16& s = sv[ks >> 1]; const int q0 = 8 * (ks & 1);
                u32x4 w; w.x = cvtpk(s[q0], s[q0 + 1]); w.y = cvtpk(s[q0 + 2], s[q0 + 3]); w.z = cvtpk(s[q0 + 4], s[q0 + 5]); w.w = cvtpk(s[q0 + 6], s[q0 + 7]);
                pk[ks] = __builtin_bit_cast(bf16x8, w);
            }
#pragma unroll
            for (int d = 0; d < 2; ++d)
#pragma unroll
                for (int ks = 0; ks < 4; ++ks) {
                    const LAS unsigned char* vb = buf + ATT_VT + (16 * ks + 4 * hi + ((lane & 15) >> 2)) * KS_PITCH + (32 * d + 16 * ((lane >> 4) & 1) + 4 * (lane & 3)) * 2;
                    const s16x4 lo = __builtin_bit_cast(s16x4, __builtin_amdgcn_ds_read_tr16_b64_v4i16((LAS v4i16_t*)vb));
                    const s16x4 hv = __builtin_bit_cast(s16x4, __builtin_amdgcn_ds_read_tr16_b64_v4i16((LAS v4i16_t*)(vb + 8 * KS_PITCH)));
                    const bf16x8 va = __builtin_shufflevector(lo, hv, 0, 1, 2, 3, 4, 5, 6, 7);
                    o[d] = __builtin_amdgcn_mfma_f32_32x32x16_bf16(va, pk[ks], o[d], 0, 0, 0);
                }
        }
    }
    {
        const float lt = l + __shfl_xor(l, 32);
        const float inv = 1.0f / lt;
        bf16_t* op = Oout + pg8::tix(tok0 + cq * 64 + qh * 32 + r, h * 64 + 4 * hi, 8, O_TILED);
#pragma unroll
        for (int d = 0; d < 2; ++d)
#pragma unroll
            for (int g = 0; g < 4; ++g) {
                u32x2 w; w.x = cvtpk(o[d][4 * g] * inv, o[d][4 * g + 1] * inv); w.y = cvtpk(o[d][4 * g + 2] * inv, o[d][4 * g + 3] * inv);
                *(u32x2*)(op + 32 * d + 8 * g) = w;
            }
    }
#undef ATT_SRC
    if (nx.valid) {
#pragma unroll
        for (int s = 0; s < 4; ++s) qf[s] = qn[s];
    }
    asm volatile("s_waitcnt lgkmcnt(0)" ::: "memory"); __builtin_amdgcn_s_barrier(); asm volatile("" ::: "memory");
}
struct Args { const float* in[17]; float* out; unsigned char* ws; };
enum { I_X = 0, I_N1, I_G1, I_U1, I_D1, I_NM, I_WIN, I_RELB, I_SINK, I_WPA, I_WPB, I_WOUT, I_N2, I_G2, I_U2, I_D2, I_NF };


#define PREP_ROWSCALE(rs_, S_, SS_) do { \
        pg8::Unit u_; int pmA_ = -1, pmB_ = -1; bool multi_ = false; \
        for (int i_ = 0; (S_).next(i_, u_); ++i_) { if (pmA_ < 0) pmA_ = u_.pm; else if (u_.pm != pmA_) { if (pmB_ < 0) pmB_ = u_.pm; else if (u_.pm != pmB_) multi_ = true; } } \
        if (pmB_ < 0) pmB_ = pmA_; \
        LAS float* tab_ = (LAS float*)(lds + RING_BYTES + 1024); \
        (rs_).SS = (SS_); (rs_).pmA = pmA_; (rs_).tab = (multi_ || pmA_ < 0) ? nullptr : tab_; \
        if ((rs_).tab) { const size_t row_ = (size_t)((tid < 256) ? pmA_ : pmB_) * 256 + (tid & 255); tab_[tid] = pg8::row_rstd((SS_), row_); } \
        __syncthreads(); } while (0)
__global__ void __launch_bounds__(NWAVES * 64, 2) mega_fwd(Args a) {
    extern __shared__ __attribute__((aligned(16))) unsigned char lds_raw[];
    LAS unsigned char* lds = (LAS unsigned char*)lds_raw;
    cg::grid_group grid = cg::this_grid();
    const int tid = threadIdx.x, lane = tid & 63, wave = __builtin_amdgcn_readfirstlane(tid >> 6);
    const int G = gridDim.x, bx = blockIdx.x;
    const int gw = bx * NWAVES + wave, NGW = G * NWAVES;
    unsigned char* ws = a.ws;
    bf16_t* WF1 = (bf16_t*)(ws + WS_WF1); bf16_t* WD1 = (bf16_t*)(ws + WS_WD1); bf16_t* WIN = (bf16_t*)(ws + WS_WIN); bf16_t* WPA = (bf16_t*)(ws + WS_WPA);
    bf16_t* WPB = (bf16_t*)(ws + WS_WPB); bf16_t* WOUT = (bf16_t*)(ws + WS_WOUT); bf16_t* WF2 = (bf16_t*)(ws + WS_WF2); bf16_t* WD2 = (bf16_t*)(ws + WS_WD2);
    bf16_t* XN = (bf16_t*)(ws + WS_XN); bf16_t* BIG = (bf16_t*)(ws + WS_BIG); bf16_t* OA = (bf16_t*)(ws + WS_OA); bf16_t* OB = (bf16_t*)(ws + WS_OB);
    float* X = a.out;
    volatile LAS unsigned* MISC = (volatile LAS unsigned*)(lds + MISC_OFF);
    if (tid < 16) MISC[tid] = 0u;
    __syncthreads();
    XcdBarrier bar = xcd_barrier_post((unsigned*)(ws + WS_BAR), MISC + 8);
#define GRID_BAR() xcd_barrier(bar)

    float* SS1 = (float*)(ws + WS_SS1); float* SS2 = (float*)(ws + WS_SS2);
    bf16_t* T = (bf16_t*)a.out;
    {
        LAS float* scr = (LAS float*)(lds + wave * 16384);
        constexpr int I_FF = (DM / 64) * (FF / 32), I_DN = (FF / 64) * (DM / 32), I_IN = (DM / 64) * (NIN / 32);
        constexpr int NITEMS = 2 * I_FF + I_DN + I_IN;
        for (int it = gw; it < NITEMS; it += NGW) {
            int r = it;
            if (r < I_FF) { transpose_item(a.in[I_G1], DM, FF, WF1, 1 | 8, a.in[I_N1], scr, r, lane); continue; } r -= I_FF;
            if (r < I_FF) { transpose_item(a.in[I_U1], DM, FF, WF1, 2 | 8, a.in[I_N1], scr, r, lane); continue; } r -= I_FF;
            if (r < I_DN) { transpose_item(a.in[I_D1], FF, DM, WD1, 8, nullptr, scr, r, lane); continue; } r -= I_DN;
            transpose_item(a.in[I_WIN], DM, NIN, WIN, 3 | 8, a.in[I_NM], scr, r, lane);
        }
        for (int mrow = 2 * gw; mrow < M; mrow += 2 * NGW) rms_rows2_bf16(a.in[I_X] + (size_t)mrow * DM, XN, (size_t)mrow, lane);
    }
    if (a.ws == nullptr) grid.sync();
    GRID_BAR();
    { pg8::Gemm g{XN, WF1, M, 2 * FF, DM, XN_TILED, 1}; pg8::StaticOrder S; S.init(M, 2 * FF, G, bx); pg8::EpiSwiglu<false> E{BIG, FF, pg8::RowScale{nullptr, nullptr, 0}};
      pg8::gemm_phase<pg8::EpiSwiglu<false>, pg8::StaticOrder, true, true>(lds, g, S, E);
      DUP(1) pg8::gemm_phase<pg8::EpiSwiglu<false>, pg8::StaticOrder, true, true>(lds, g, S, E); }
    GRID_BAR();
    DUP(20) { GRID_BAR(); GRID_BAR(); GRID_BAR(); GRID_BAR(); GRID_BAR(); GRID_BAR(); GRID_BAR(); GRID_BAR(); }
    { pg8::Gemm g{BIG, WD1, M, DM, FF, 1, 1}; pg8::StaticOrder S; S.init(M, DM, G, bx); pg8::EpiResidB<true> E{a.in[I_X], XN, 0.5f, SS1};
      pg8::gemm_phase<pg8::EpiResidB<true>, pg8::StaticOrder, true, false>(lds, g, S, E);
      DUP(2) pg8::gemm_phase<pg8::EpiResidB<true>, pg8::StaticOrder, true, true>(lds, g, S, E); }
    GRID_BAR();
    { pg8::Gemm g{XN, WIN, M, NIN, DM, XN_TILED, 1}; pg8::StaticOrder S; S.init(M, NIN, G, bx); pg8::RowScale RS; PREP_ROWSCALE(RS, S, SS1); pg8::EpiProjIn E{BIG, BIG + (size_t)M * pg8::PROJ_LD, RS};
      pg8::gemm_phase<pg8::EpiProjIn, pg8::StaticOrder, true, true>(lds, g, S, E);
      DUP(4) pg8::gemm_phase<pg8::EpiProjIn, pg8::StaticOrder, true, true>(lds, g, S, E); }
    {
        constexpr int NU4 = (M / 256) * (NIN / 256);
        const int rounds = (NU4 + G - 1) / G, nbusy = NU4 - (rounds - 1) * G;
        const int nidle = G - nbusy;
        const bool all = (nidle <= 0);
        if (all || bx >= nbusy) {
            int t4 = threadIdx.x; asm volatile("" : "+v"(t4)); const int lane = t4 & 63, wave = __builtin_amdgcn_readfirstlane(t4 >> 6), gw = bx * NWAVES + wave;
            LAS float* scr = (LAS float*)(lds + wave * 16384);
            constexpr int I_FF = (DM / 64) * (FF / 32), I_DN = (FF / 64) * (DM / 32), I_P = (512 / 64) * (DM / 32), I_O = (DM / 64) * (DM / 32);
            constexpr int NLATE = 2 * I_P + I_O + 2 * I_FF + I_DN;
            const int w0 = all ? gw : (bx - nbusy) * NWAVES + wave, nw = all ? NGW : nidle * NWAVES;
            for (int it = w0; it < NLATE; it += nw) {
                int r = it;
                if (r < I_P) { transpose_item(a.in[I_WPA], 512, DM, WPA, 8, nullptr, scr, r, lane); continue; } r -= I_P;
                if (r < I_P) { transpose_item(a.in[I_WPB], 512, DM, WPB, 8, nullptr, scr, r, lane); continue; } r -= I_P;
                if (r < I_O) { transpose_item(a.in[I_WOUT], DM, DM, WOUT, 8, nullptr, scr, r, lane); continue; } r -= I_O;
                if (r < I_FF) { transpose_item(a.in[I_G2], DM, FF, WF2, 1 | 8, a.in[I_N2], scr, r, lane); continue; } r -= I_FF;
                if (r < I_FF) { transpose_item(a.in[I_U2], DM, FF, WF2, 2 | 8, a.in[I_N2], scr, r, lane); continue; } r -= I_FF;
                transpose_item(a.in[I_D2], FF, DM, WD2, 8, nullptr, scr, r, lane);
            }
        }
    }
    GRID_BAR();
    {
        const int vcu = (G % 8 == 0) ? (bx % 8) * (G / 8) + bx / 8 : bx;
        int tid5_ = threadIdx.x; asm volatile("" : "+v"(tid5_));
        const int tid = tid5_, lane = tid & 63, wave = __builtin_amdgcn_readfirstlane(tid >> 6);
#define ATT_DESC(u_, d_) do { const int uu_ = (u_); (d_).valid = uu_ < 2048; (d_).isB = uu_ >= 1024; \
            if (uu_ < 1024) { const int i_ = uu_ >> 8, w_ = uu_ & 255; (d_).b = (w_ >> 6) + 4 * i_; (d_).hx = (w_ >> 3) & 7; (d_).cx = 4 * (((w_ & 7) + 2 * i_) & 7); } \
            else { const int v_ = uu_ - 1024; (d_).b = v_ >> 6; (d_).hx = (v_ >> 5) & 1; (d_).cx = v_ & 31; } } while (0)
        {
            LAS float* tabs = (LAS float*)(lds + ATT_TAB);
            for (int i = tid; i < 8 * 192; i += NWAVES * 64) tabs[i] = a.in[I_RELB][i] * LOG2E;
            if (tid < 8) tabs[8 * 192 + tid] = a.in[I_SINK][tid] * LOG2E;
            __syncthreads();
        }
        for (int rep = 0; rep < (PROBE_DUP == 5 ? 2 : 1); ++rep) {
        AttnNext cur; ATT_DESC(vcu, cur);
        bf16x8 kreg, vreg, qf[4];
        if (cur.valid) { const bf16_t *kp, *vp, *qp; attn_first_ptrs(BIG, cur.isB, cur.b, cur.hx, cur.cx, tid, lane, wave, kp, vp, qp);
            kreg = *(const bf16x8*)kp; vreg = *(const bf16x8*)vp;
#pragma unroll
            for (int s = 0; s < 4; ++s) qf[s] = *(const bf16x8*)(qp + 16 * s); }
        for (int u = vcu; u < 2048; u += G) {
            AttnNext nx; ATT_DESC(u + G, nx);
            if (!cur.isB) attn_wg_unit<false>(BIG, OA, cur.b, cur.hx, cur.cx, lds, a.in[I_RELB], a.in[I_SINK], tid, lane, wave, kreg, vreg, qf, nx);
            else attn_wg_unit<true>(BIG, OB, cur.b, cur.hx, cur.cx, lds, a.in[I_RELB], a.in[I_SINK], tid, lane, wave, kreg, vreg, qf, nx);
            cur = nx;
        }
        }
#undef ATT_DESC
    }
    GRID_BAR();
    { pg8::Gemm g{OA, WPA, 2 * M, 2 * DM, 512, O_TILED, 1}; pg8::PairOrder S; S.init(M, DM, G, bx); pg8::EpiGatePair E{BIG + (size_t)M * pg8::PROJ_LD, T};
      pg8::gemm_phase<pg8::EpiGatePair, pg8::PairOrder, true, true>(lds, g, S, E);
      DUP(6) pg8::gemm_phase<pg8::EpiGatePair, pg8::PairOrder, true, true>(lds, g, S, E); }
    GRID_BAR();
    { pg8::Gemm g{T, WOUT, M, DM, DM, T_TILED, 1}; pg8::StaticOrder S; S.init(M, DM, G, bx); pg8::EpiResidB<false> E{XN, XN, 1.0f, SS2};
      pg8::gemm_phase<pg8::EpiResidB<false>, pg8::StaticOrder, true, true>(lds, g, S, E); }
    GRID_BAR();
    { pg8::Gemm g{XN, WF2, M, 2 * FF, DM, XN_TILED, 1}; pg8::StaticOrder S; S.init(M, 2 * FF, G, bx); pg8::RowScale RS; PREP_ROWSCALE(RS, S, SS2); pg8::EpiSwiglu<true> E{BIG, FF, RS};
      pg8::gemm_phase<pg8::EpiSwiglu<true>, pg8::StaticOrder, true, true>(lds, g, S, E);
      DUP(9) pg8::gemm_phase<pg8::EpiSwiglu<true>, pg8::StaticOrder, true, true>(lds, g, S, E); }
    GRID_BAR();
    { pg8::Gemm g{BIG, WD2, M, DM, FF, 1, 1}; pg8::StaticOrder S; S.init(M, DM, G, bx); pg8::EpiResidB<false> E{XN, XN, 0.5f, SS1};
      pg8::gemm_phase<pg8::EpiResidB<false>, pg8::StaticOrder, true, true>(lds, g, S, E); }
    GRID_BAR();
    { int t11 = threadIdx.x; asm volatile("" : "+v"(t11));
      const int lane11 = t11 & 63, gw11 = bx * NWAVES + __builtin_amdgcn_readfirstlane(t11 >> 6);
      for (int mrow = 2 * gw11; mrow < M; mrow += 2 * NGW) final_rows2(XN, SS1, (size_t)mrow, a.in[I_NF], X + (size_t)mrow * DM, lane11); }
}

extern "C" void kernel_launch(void* const* d_in, const int* in_sizes, int n_in, void* d_out, int out_size, void* d_ws, size_t ws_size, hipStream_t stream) {
    static int grid = 0;
    if (grid == 0) {
        if (n_in != 17 || in_sizes[0] != M * DM || out_size != M * DM || ws_size < WS_END) { fprintf(stderr, "kernel_launch: unexpected shapes (n_in %d, in0 %d, out %d, ws %zu)\n", n_in, n_in > 0 ? in_sizes[0] : -1, out_size, ws_size); grid = -1; return; }
        int dev = 0, cus = 0, per_cu = 0;
        (void)hipGetDevice(&dev);
        (void)hipDeviceGetAttribute(&cus, hipDeviceAttributeMultiprocessorCount, dev);
        if (hipFuncSetAttribute((const void*)mega_fwd, hipFuncAttributeMaxDynamicSharedMemorySize, LDS_BYTES) != hipSuccess) { fprintf(stderr, "kernel_launch: hipFuncSetAttribute failed\n"); grid = -1; return; }
        if (hipOccupancyMaxActiveBlocksPerMultiprocessor(&per_cu, (const void*)mega_fwd, NWAVES * 64, LDS_BYTES) != hipSuccess || per_cu < 1) { fprintf(stderr, "kernel_launch: occupancy query says %d\n", per_cu); per_cu = 1; }
        (void)hipGetLastError();
        grid = cus * 1;
        fprintf(stderr, "kernel_launch: grid %d (cus %d, per_cu %d)\n", grid, cus, per_cu);
    }
    if (grid < 0) return;
    if (hipMemsetAsync((char*)d_ws + WS_BAR, 0, BAR_ZERO_BYTES, stream) != hipSuccess) { fprintf(stderr, "kernel_launch: memset failed\n"); return; }
    Args a{};
    for (int i = 0; i < 17; ++i) a.in[i] = (const float*)d_in[i];
    a.out = (float*)d_out; a.ws = (unsigned char*)d_ws;
    void* args[] = {&a};
    hipError_t e = hipLaunchCooperativeKernel((const void*)mega_fwd, dim3(grid), dim3(NWAVES * 64), args, LDS_BYTES, stream);
    if (e != hipSuccess) fprintf(stderr, "kernel_launch: cooperative launch failed: %s (grid %d)\n", hipGetErrorString(e), grid);
}
```

```cpp
#include <hip/hip_runtime.h>
#include <hip/hip_cooperative_groups.h>
#include <cstdio>
#include <cstdint>
namespace cg = cooperative_groups;
#define XN_TILED 0
#define T_TILED 0
#define O_TILED 0
#ifndef PROBE_DUP
#define PROBE_DUP -1
#endif
#define DUP(k) if constexpr (PROBE_DUP == (k))
namespace pg8 {
#define PG8_LAS __attribute__((address_space(3)))
typedef unsigned short bf16_t;
typedef short bf16x8 __attribute__((ext_vector_type(8)));
typedef float f32x4 __attribute__((ext_vector_type(4)));
typedef unsigned u32x4 __attribute__((ext_vector_type(4)));
constexpr int BM = 256, BK = 64, HALF = 128, HTB = HALF * BK * 2  , STAGE_BYTES = 8 * HTB, NXCD = 8, WGM = 8;

__host__ __device__ __forceinline__ int lds_byte(int r, int c) { const int st = (r >> 4) * 2 + (c >> 5), rr = r & 15, cc = c & 31, ob = rr * 64 + cc * 2; return st * 1024 + (ob ^ (((ob >> 9) & 1) << 5)); }
__host__ __device__ __forceinline__ void stage_rc(int b, int& R, int& C) { const int st = b / 1024, sb = b % 1024, swz = sb ^ (((sb >> 9) & 1) << 5); R = (st >> 1) * 16 + swz / 64; C = (st & 1) * 32 + (swz % 64) / 2; }
__host__ __device__ __forceinline__ int perm32(int rho) { const int n = rho >> 4, i = rho & 15; return 8 * (i >> 2) + 4 * n + (i & 3); }

struct Unit { int pm, pn; };
struct Gemm { const bf16_t* A; const bf16_t* Bt; int M, N, K; int tiledA, tiledB; };

struct StaticOrder {
    int nM, nN, nwg, G, c;
    __host__ __device__ void init(int M, int N, int G_, int c_) { nM = M / BM; nN = N / BM; nwg = nM * nN; G = G_; c = c_; }
    __host__ __device__ bool next(int i, Unit& u) const {
        const long L = (long)i * G + c; if (L >= nwg) return false;
        int wgid = (int)L; { const int q = nwg / NXCD, r = nwg % NXCD, xcd = wgid % NXCD, off = wgid / NXCD; wgid = (xcd < r ? xcd * (q + 1) : r * (q + 1) + (xcd - r) * q) + off; }
        const int nig = WGM * nN, gid = wgid / nig, fm = gid * WGM, gsz = (nM - fm) < WGM ? (nM - fm) : WGM;
        u.pm = fm + ((wgid % nig) % gsz); u.pn = (wgid % nig) / gsz; return true;
    }
    __device__ __forceinline__ void a_ready(const Unit&) const {}
    __device__ __forceinline__ void done(const Unit&) const {}
};
__device__ __forceinline__ unsigned cvt_pk_bf16(float lo, float hi) { unsigned r; asm volatile("v_cvt_pk_bf16_f32 %0, %1, %2" : "=v"(r) : "v"(lo), "v"(hi)); return r; }
typedef float f32x2 __attribute__((ext_vector_type(2)));
typedef unsigned u32x2 __attribute__((ext_vector_type(2)));
#ifndef XN_TILED
#define XN_TILED 0
#endif
#ifndef T_TILED
#define T_TILED 0
#endif
#ifndef O_TILED
#define O_TILED 0
#endif
__device__ __forceinline__ size_t tix(size_t row, int col, int ktiles, bool tiled = true) { return tiled ? ((((row >> 8) * ktiles + (col >> 6)) << 14) + ((row & 255) << 6)) + (col & 63) : row * (size_t)(64 * ktiles) + col; }
__device__ __forceinline__ float bf_lo(unsigned w) { return __uint_as_float(w << 16); }
__device__ __forceinline__ float bf_hi(unsigned w) { return __uint_as_float(w & 0xffff0000u); }
__device__ __forceinline__ float sigm(float x) { return __builtin_amdgcn_rcpf(1.0f + __builtin_amdgcn_exp2f(-1.4426950408889634f * x)); }
constexpr int PROJ_LD = 2304;
__device__ __forceinline__ size_t gidx(int stage, int pm, int pt, int rowp, int col) { return ((((size_t)stage * 128 + pm) * 4 + pt) * 256 + rowp) * 256 + col; }
constexpr float QSCALE = 0.125f * 1.4426950408889634f;

__device__ __forceinline__ float row_rstd(const float* SS, size_t row) {
    const f32x4* p = (const f32x4*)(SS + row * 16);
    const f32x4 a = p[0], b = p[1], c = p[2], d = p[3];
    const float s = ((a[0] + a[1]) + (a[2] + a[3])) + ((b[0] + b[1]) + (b[2] + b[3])) + ((c[0] + c[1]) + (c[2] + c[3])) + ((d[0] + d[1]) + (d[2] + d[3]));
    return 1.0f / sqrtf(s * (1.0f / 1024.0f) + 1e-6f);
}
struct RowScale {
    const float* SS; const PG8_LAS float* tab; int pmA;
    __device__ __forceinline__ float get(const Unit& u, size_t row) const { return tab ? tab[(u.pm != pmA ? 256 : 0) + (int)(row & 255)] : row_rstd(SS, row); }
    __device__ __forceinline__ void get8(const Unit& u, int row0, float (&rs)[2][4]) const {
        if (__builtin_amdgcn_readfirstlane((int)(tab != nullptr))) {
            const PG8_LAS float* t = tab + (u.pm != pmA ? 256 : 0) + (row0 & 255);
#pragma unroll
            for (int ai = 0; ai < 2; ++ai)
#pragma unroll
                for (int m = 0; m < 4; ++m) rs[ai][m] = t[ai * HALF + m * 16];
        } else {
#pragma unroll
            for (int ai = 0; ai < 2; ++ai)
#pragma unroll
                for (int m = 0; m < 4; ++m) rs[ai][m] = row_rstd(SS, (size_t)(row0 + ai * HALF + m * 16));
        }
    }
};
template <bool SCALE> struct EpiSwiglu {
    static constexpr bool PERM = true, AFTER_DRAIN = false, PAIRED = false;
    bf16_t* H; int ldh; RowScale RS;
    __device__ __forceinline__ void operator()(const f32x4 (&acc)[2][2][4][2], const Unit& u, int wr, int wc, int fr, int fq) const {
        const int row0 = u.pm * BM + wr * 64 + fr, col0 = u.pn * HALF + wc * 32 + 8 * fq;
        float rsv[2][4];
        if (SCALE) RS.get8(u, row0, rsv);
#pragma unroll
        for (int ai = 0; ai < 2; ++ai)
#pragma unroll
            for (int m = 0; m < 4; ++m) {
                const size_t row = (size_t)(row0 + ai * HALF + m * 16);
                bf16_t* p = H + ((size_t)(u.pm * (ldh >> 6) + (col0 >> 6)) * BM + (row & (BM - 1))) * BK + (col0 & 63);
                f32x4 g0 = acc[ai][0][m][0], g1 = acc[ai][0][m][1], u0 = acc[ai][1][m][0], u1 = acc[ai][1][m][1];
                if (SCALE) { const float rs = rsv[ai][m]; g0 = g0 * rs; g1 = g1 * rs; u0 = u0 * rs; u1 = u1 * rs; }
                u32x4 w;
                w.x = cvt_pk_bf16(g0[0] * sigm(g0[0]) * u0[0], g0[1] * sigm(g0[1]) * u0[1]);
                w.y = cvt_pk_bf16(g0[2] * sigm(g0[2]) * u0[2], g0[3] * sigm(g0[3]) * u0[3]);
                w.z = cvt_pk_bf16(g1[0] * sigm(g1[0]) * u1[0], g1[1] * sigm(g1[1]) * u1[1]);
                w.w = cvt_pk_bf16(g1[2] * sigm(g1[2]) * u1[2], g1[3] * sigm(g1[3]) * u1[3]);
                __builtin_nontemporal_store(w, (u32x4*)p);
            }
    }
};
template <bool BASE_F32> struct EpiResidB {
    static constexpr bool PERM = true, AFTER_DRAIN = false, PAIRED = false;
    const void* base; bf16_t* X; float alpha; float* SS;
    __device__ __forceinline__ void operator()(const f32x4 (&acc)[2][2][4][2], const Unit& u, int wr, int wc, int fr, int fq) const {
        const int row0 = u.pm * BM + wr * 64 + fr, col0 = u.pn * BM + wc * 32 + 8 * fq;
#pragma unroll
        for (int ai = 0; ai < 2; ++ai) {
            f32x4 b0[4][2], b1[4][2];
            if (BASE_F32) {
#pragma unroll
                for (int m = 0; m < 4; ++m)
#pragma unroll
                    for (int bj = 0; bj < 2; ++bj) { const float* p = (const float*)base + (size_t)(row0 + ai * HALF + m * 16) * 1024 + col0 + bj * HALF; b0[m][bj] = __builtin_nontemporal_load((const f32x4*)p); b1[m][bj] = __builtin_nontemporal_load((const f32x4*)(p + 4)); }
            } else {
                u32x4 t[4][2];
#pragma unroll
                for (int m = 0; m < 4; ++m)
#pragma unroll
                    for (int bj = 0; bj < 2; ++bj) t[m][bj] = *(const u32x4*)((const bf16_t*)base + tix((size_t)(row0 + ai * HALF + m * 16), col0 + bj * HALF, 16, XN_TILED));
                __builtin_amdgcn_sched_barrier(0);
#pragma unroll
                for (int m = 0; m < 4; ++m)
#pragma unroll
                    for (int bj = 0; bj < 2; ++bj) { const u32x4 w = t[m][bj]; b0[m][bj] = (f32x4){bf_lo(w.x), bf_hi(w.x), bf_lo(w.y), bf_hi(w.y)}; b1[m][bj] = (f32x4){bf_lo(w.z), bf_hi(w.z), bf_lo(w.w), bf_hi(w.w)}; }
            }
            __builtin_amdgcn_sched_barrier(0);
#pragma unroll
            for (int m = 0; m < 4; ++m) {
                const size_t row = (size_t)(row0 + ai * HALF + m * 16);
                float ss = 0.f;
#pragma unroll
                for (int bj = 0; bj < 2; ++bj) {
                    const f32x4 v0 = b0[m][bj] + acc[ai][bj][m][0] * alpha, v1 = b1[m][bj] + acc[ai][bj][m][1] * alpha;
                    ss += ((v0[0] * v0[0] + v0[1] * v0[1]) + (v0[2] * v0[2] + v0[3] * v0[3])) + ((v1[0] * v1[0] + v1[1] * v1[1]) + (v1[2] * v1[2] + v1[3] * v1[3]));
                    u32x4 w; w.x = cvt_pk_bf16(v0[0], v0[1]); w.y = cvt_pk_bf16(v0[2], v0[3]); w.z = cvt_pk_bf16(v1[0], v1[1]); w.w = cvt_pk_bf16(v1[2], v1[3]);
                    *(u32x4*)(X + tix(row, col0 + bj * HALF, 16, XN_TILED)) = w;
                }
                ss += __shfl_xor(ss, 16); ss += __shfl_xor(ss, 32);
                if (fq == 0) SS[row * 16 + u.pn * 4 + wc] = ss;
            }
        }
    }
};
struct EpiProjIn {
    static constexpr bool PERM = true, AFTER_DRAIN = false, PAIRED = false;
    bf16_t* P; bf16_t* GT; RowScale RS;
    __device__ __forceinline__ void operator()(const f32x4 (&acc)[2][2][4][2], const Unit& u, int wr, int wc, int fr, int fq) const {
        const int row0 = u.pm * BM + wr * 64 + fr;
        const int kind = (u.pn < 2 || u.pn == 6 || u.pn == 7) ? 1 : (u.pn >= 9 ? 2 : 0);
        float rsv[2][4]; RS.get8(u, row0, rsv);
#pragma unroll
        for (int ai = 0; ai < 2; ++ai)
#pragma unroll
            for (int m = 0; m < 4; ++m) {
                const size_t row = (size_t)(row0 + ai * HALF + m * 16);
                const float rs = rsv[ai][m];
                if (kind == 2) {
                    const int gp = u.pn - 9;
                    bf16_t* p = GT + gidx(0, u.pm, gp >> 1, (int)(row & 255), (gp & 1) * HALF + wc * 32 + 8 * fq);
                    float rr[8], sb[8];
#pragma unroll
                    for (int n = 0; n < 2; ++n)
#pragma unroll
                        for (int j = 0; j < 4; ++j) {
                            const float ga = __builtin_fmaxf(acc[ai][0][m][n][j] * rs, -30.f), gb = __builtin_fmaxf(acc[ai][1][m][n][j] * rs, -30.f);
                            const float ea = __builtin_amdgcn_exp2f(-1.4426950408889634f * ga), eb = __builtin_amdgcn_exp2f(-1.4426950408889634f * gb);
                            rr[n * 4 + j] = (1.0f + eb) * __builtin_amdgcn_rcpf(1.0f + ea); sb[n * 4 + j] = __builtin_amdgcn_rcpf(1.0f + eb);
                        }
                    u32x4 w; w.x = cvt_pk_bf16(rr[0], rr[1]); w.y = cvt_pk_bf16(rr[2], rr[3]); w.z = cvt_pk_bf16(rr[4], rr[5]); w.w = cvt_pk_bf16(rr[6], rr[7]);
                    __builtin_nontemporal_store(w, (u32x4*)p);
                    w.x = cvt_pk_bf16(sb[0], sb[1]); w.y = cvt_pk_bf16(sb[2], sb[3]); w.z = cvt_pk_bf16(sb[4], sb[5]); w.w = cvt_pk_bf16(sb[6], sb[7]);
                    __builtin_nontemporal_store(w, (u32x4*)(p + gidx(1, 0, 0, 0, 0)));
                } else {
                    bf16_t* p = P + row * PROJ_LD + u.pn * BM + wc * 32 + 8 * fq;
                    const float sc = kind == 1 ? rs * QSCALE : rs;
#pragma unroll
                    for (int bj = 0; bj < 2; ++bj) {
                        const f32x4 v0 = acc[ai][bj][m][0] * sc, v1 = acc[ai][bj][m][1] * sc;
                        u32x4 w; w.x = cvt_pk_bf16(v0[0], v0[1]); w.y = cvt_pk_bf16(v0[2], v0[3]); w.z = cvt_pk_bf16(v1[0], v1[1]); w.w = cvt_pk_bf16(v1[2], v1[3]);
                        __builtin_nontemporal_store(w, (u32x4*)(p + bj * HALF));
                    }
                }
            }
    }
};
struct PairOrder {
    StaticOrder base;
    __host__ __device__ void init(int M, int N, int G_, int c_) { base.init(M, N, G_, c_); }
    __host__ __device__ bool next(int i, Unit& u) const { Unit b; if (!base.next(i >> 1, b)) return false; u.pm = b.pm + (i & 1) * base.nM; u.pn = b.pn + (i & 1) * base.nN; return true; }
    __device__ __forceinline__ void a_ready(const Unit&) const {}
    __device__ __forceinline__ void done(const Unit&) const {}
};
struct EpiGatePair {
    static constexpr bool PERM = true, AFTER_DRAIN = false, PAIRED = true;
    const bf16_t* P; bf16_t* T;
    __device__ __forceinline__ void operator()(f32x4 (&acc)[2][2][4][2], const Unit& u, int wr, int wc, int fr, int fq) const {
        const int stage = u.pm >= 128 ? 1 : 0, pm = u.pm & 127, pn = u.pn & 3;
        const int row0 = pm * BM + wr * 64 + fr, col0 = pn * BM + wc * 32 + 8 * fq;
        u32x4 gt[2][4][2];
#pragma unroll
        for (int ai = 0; ai < 2; ++ai)
#pragma unroll
            for (int m = 0; m < 4; ++m)
#pragma unroll
                for (int bj = 0; bj < 2; ++bj) gt[ai][m][bj] = *(const u32x4*)(P + gidx(stage, pm, pn, wr * 64 + fr + ai * HALF + m * 16, wc * 32 + 8 * fq + bj * HALF));
        __builtin_amdgcn_sched_barrier(0);
#pragma unroll
        for (int ai = 0; ai < 2; ++ai)
#pragma unroll
            for (int m = 0; m < 4; ++m) {
                const size_t row = (size_t)(row0 + ai * HALF + m * 16);
#pragma unroll
                for (int bj = 0; bj < 2; ++bj) {
                    const int c = col0 + bj * HALF;
                    const u32x4 g = gt[ai][m][bj];
                    f32x4 v0 = acc[ai][bj][m][0], v1 = acc[ai][bj][m][1];
                    v0[0] *= bf_lo(g.x); v0[1] *= bf_hi(g.x); v0[2] *= bf_lo(g.y); v0[3] *= bf_hi(g.y);
                    v1[0] *= bf_lo(g.z); v1[1] *= bf_hi(g.z); v1[2] *= bf_lo(g.w); v1[3] *= bf_hi(g.w);
                    if (stage == 0) { acc[ai][bj][m][0] = v0; acc[ai][bj][m][1] = v1; }
                    else { u32x4 w; w.x = cvt_pk_bf16(v0[0], v0[1]); w.y = cvt_pk_bf16(v0[2], v0[3]); w.z = cvt_pk_bf16(v1[0], v1[1]); w.w = cvt_pk_bf16(v1[2], v1[3]);
                           *(u32x4*)(T + tix(row, c, 16, T_TILED)) = w; }
                }
            }
    }
};
template <class Epi, class Sched, bool ALIGN_EPI = false, bool SP2 = false, bool NTA = false  >
__device__ __forceinline__ void gemm_phase(PG8_LAS unsigned char* lds, const Gemm g, const Sched& S, const Epi& E) {
    int tid_ = threadIdx.x; asm volatile("" : "+v"(tid_));
    const int tid = tid_, wid = __builtin_amdgcn_readfirstlane(tid >> 6), lane = tid & 63, wr = wid >> 2, wc = wid & 3, fr = lane & 15, fq = lane >> 4;
    const int K = g.K, nt = K / BK;
    unsigned voffA[2], voffB[2];
#pragma unroll
    for (int i = 0; i < 2; ++i) { int R, C; stage_rc(tid * 16 + i * 8192, R, C); const int Rb = Epi::PERM ? ((R & ~31) + perm32(R & 31)) : R;
        voffA[i] = g.tiledA ? (unsigned)(R * BK + C) * 2u : (unsigned)(R * K + C) * 2u; voffB[i] = g.tiledB ? (unsigned)(Rb * BK + C) * 2u : (unsigned)(Rb * K + C) * 2u; }
    const size_t kstep = (size_t)(BK * 2);
    const size_t hstep = (size_t)HALF * K * 2;
    const size_t tstep = 2 * hstep;
    const size_t kstepA = g.tiledA ? (size_t)(BM * BK * 2) : kstep, hstepA = g.tiledA ? (size_t)(HALF * BK * 2) : hstep, tstepA = g.tiledA ? (size_t)nt * (BM * BK * 2) : tstep;
    const size_t kstepB = g.tiledB ? (size_t)(BM * BK * 2) : kstep, hstepB = g.tiledB ? (size_t)(HALF * BK * 2) : hstep, tstepB = g.tiledB ? (size_t)nt * (BM * BK * 2) : tstep;
    const unsigned ldsw = (unsigned)wid * 1024u;
    const int aoff = lds_byte(wr * 64 + fr, fq * 8), boff = lds_byte(wc * 32 + fr, fq * 8);
#define PG8_SA(b, h) (((b) * 2 + (h)) * HTB)
#define PG8_SB(b, h) ((4 + (b) * 2 + (h)) * HTB)
#define PG8_STAGE(bufoff, gbase, voff) do { _Pragma("unroll") for (int _i = 0; _i < 2; ++_i) \
        __builtin_amdgcn_global_load_lds((const unsigned*)((const char*)(gbase) + (voff)[_i]), (PG8_LAS unsigned*)(lds + (bufoff) + ldsw + _i * 8192), 16, 0, 0); } while (0)
#define PG8_STAGEA(bufoff, gbase, voff) do { _Pragma("unroll") for (int _i = 0; _i < 2; ++_i) { \
        if constexpr (NTA) __builtin_amdgcn_global_load_lds((const unsigned*)((const char*)(gbase) + (voff)[_i]), (PG8_LAS unsigned*)(lds + (bufoff) + ldsw + _i * 8192), 16, 0, 2); \
        else __builtin_amdgcn_global_load_lds((const unsigned*)((const char*)(gbase) + (voff)[_i]), (PG8_LAS unsigned*)(lds + (bufoff) + ldsw + _i * 8192), 16, 0, 0); } } while (0)
#define PG8_LDA(dst, b, h) do { _Pragma("unroll") for (int m = 0; m < 4; ++m) _Pragma("unroll") for (int k = 0; k < 2; ++k) dst[m][k] = *(const PG8_LAS bf16x8*)(lds + PG8_SA(b, h) + aoff + m * 2048 + k * 1024); } while (0)
#define PG8_LDB(dst, b, h) do { _Pragma("unroll") for (int n = 0; n < 2; ++n) _Pragma("unroll") for (int k = 0; k < 2; ++k) dst[n][k] = *(const PG8_LAS bf16x8*)(lds + PG8_SB(b, h) + boff + n * 2048 + k * 1024); } while (0)
#define PG8_MMA(ai, bj, At, Bt) do { __builtin_amdgcn_s_setprio(1); _Pragma("unroll") for (int m = 0; m < 4; ++m) _Pragma("unroll") for (int n = 0; n < 2; ++n) _Pragma("unroll") for (int k = 0; k < 2; ++k) \
        acc[ai][bj][m][n] = __builtin_amdgcn_mfma_f32_16x16x32_bf16(Bt[n][k], At[m][k], acc[ai][bj][m][n], 0, 0, 0); __builtin_amdgcn_s_setprio(0); } while (0)
#define PG8_WAIT_V(n) asm volatile("s_waitcnt vmcnt(" #n ")" ::: "memory")
#define PG8_WAIT_L(n) asm volatile("s_waitcnt lgkmcnt(" #n ")" ::: "memory")
#define PG8_BAR __builtin_amdgcn_s_barrier()
#define PG8_SCHED __builtin_amdgcn_sched_barrier(0)
    Unit cur, nxt; int ui = 0;
    if (!S.next(0, cur)) return;
    f32x4 acc[2][2][4][2];
#pragma unroll
    for (int a = 0; a < 2; ++a)
#pragma unroll
        for (int b = 0; b < 2; ++b)
#pragma unroll
            for (int m = 0; m < 4; ++m)
#pragma unroll
                for (int n = 0; n < 2; ++n) acc[a][b][m][n] = (f32x4){0.f, 0.f, 0.f, 0.f};
    bf16x8 At[4][2], B0[2][2], B1[2][2];
    const char* cA = (const char*)g.A + (size_t)cur.pm * tstepA; const char* cB = (const char*)g.Bt + (size_t)cur.pn * tstepB;
    S.a_ready(cur);
    if constexpr (SP2) {
        PG8_STAGE(PG8_SB(0, 0), cB, voffB); PG8_STAGE(PG8_SB(0, 1), cB + hstepB, voffB); PG8_STAGEA(PG8_SA(0, 0), cA, voffA); PG8_STAGEA(PG8_SA(0, 1), cA + hstepA, voffA);
        if (wr == 1) PG8_BAR;
        PG8_WAIT_V(2); PG8_BAR;
        PG8_STAGE(PG8_SB(1, 0), cB + kstepB, voffB); PG8_STAGEA(PG8_SA(1, 0), cA + kstepA, voffA); PG8_STAGE(PG8_SB(1, 1), cB + hstepB + kstepB, voffB);
        PG8_WAIT_V(6); PG8_BAR;
    } else {
        PG8_STAGE(PG8_SB(0, 0), cB, voffB); PG8_STAGEA(PG8_SA(0, 0), cA, voffA); PG8_STAGE(PG8_SB(0, 1), cB + hstepB, voffB); PG8_STAGEA(PG8_SA(0, 1), cA + hstepA, voffA);
        if (wr == 1) PG8_BAR;
        PG8_WAIT_V(4); PG8_BAR;
        PG8_STAGE(PG8_SB(1, 0), cB + kstepB, voffB); PG8_STAGEA(PG8_SA(1, 0), cA + kstepA, voffA); PG8_STAGE(PG8_SB(1, 1), cB + hstepB + kstepB, voffB);
        PG8_WAIT_V(6); PG8_BAR;
    }
    for (;;) {
        const bool has_next = S.next(ui + 1, nxt);
        const char* nA = has_next ? (const char*)g.A + (size_t)nxt.pm * tstepA : cA; const char* nB = has_next ? (const char*)g.Bt + (size_t)nxt.pn * tstepB : cB;
        for (int t = 0; t < nt; t += 2) {
            const bool last = (t == nt - 2);
            const char* a1 = cA + (size_t)(t + 1) * kstepA;
            const char* a2 = last ? nA : cA + (size_t)(t + 2) * kstepA; const char* b2 = last ? nB : cB + (size_t)(t + 2) * kstepB;
            const char* a3 = a2 + kstepA; const char* b3 = b2 + kstepB;
            if (last && has_next) S.a_ready(nxt);
            if constexpr (SP2) {
            PG8_LDB(B0, 0, 0); PG8_LDB(B1, 0, 1); PG8_SCHED; PG8_LDA(At, 0, 0); PG8_STAGEA(PG8_SA(1, 1), a1 + hstepA, voffA);
            PG8_WAIT_V(8); PG8_WAIT_L(0); PG8_BAR; PG8_MMA(0, 0, At, B0); PG8_MMA(0, 1, At, B1); PG8_BAR; PG8_SCHED;
            PG8_LDA(At, 0, 1); PG8_STAGE(PG8_SB(0, 0), b2, voffB); PG8_STAGE(PG8_SB(0, 1), b2 + hstepB, voffB); PG8_STAGEA(PG8_SA(0, 0), a2, voffA);
            PG8_WAIT_V(8); PG8_WAIT_L(0); PG8_BAR; PG8_MMA(1, 0, At, B0); PG8_MMA(1, 1, At, B1); PG8_BAR; PG8_SCHED;
            PG8_LDB(B0, 1, 0); PG8_LDB(B1, 1, 1); PG8_SCHED; PG8_LDA(At, 1, 0); PG8_STAGEA(PG8_SA(0, 1), a2 + hstepA, voffA);
            PG8_WAIT_V(8); PG8_WAIT_L(0); PG8_BAR; PG8_MMA(0, 0, At, B0); PG8_MMA(0, 1, At, B1); PG8_BAR; PG8_SCHED;
            PG8_LDA(At, 1, 1); PG8_STAGE(PG8_SB(1, 0), b3, voffB); PG8_STAGE(PG8_SB(1, 1), b3 + hstepB, voffB); PG8_STAGEA(PG8_SA(1, 0), a3, voffA);
            PG8_WAIT_V(8); PG8_WAIT_L(0); PG8_BAR; PG8_MMA(1, 0, At, B0); PG8_MMA(1, 1, At, B1); PG8_BAR; PG8_SCHED;
            } else {
            PG8_LDB(B0, 0, 0); PG8_SCHED; PG8_LDA(At, 0, 0); PG8_STAGEA(PG8_SA(1, 1), a1 + hstepA, voffA);
            PG8_WAIT_L(8); PG8_BAR; PG8_WAIT_L(0); PG8_MMA(0, 0, At, B0); PG8_BAR; PG8_SCHED;
            PG8_LDB(B1, 0, 1); PG8_STAGE(PG8_SB(0, 0), b2, voffB);
            PG8_BAR; PG8_WAIT_L(0); PG8_MMA(0, 1, At, B1); PG8_BAR;
            PG8_LDA(At, 0, 1); PG8_STAGEA(PG8_SA(0, 0), a2, voffA);
            PG8_BAR; PG8_WAIT_L(0); PG8_MMA(1, 0, At, B0); PG8_BAR; PG8_SCHED;
            PG8_STAGE(PG8_SB(0, 1), b2 + hstepB, voffB);
            PG8_WAIT_V(6); PG8_BAR; PG8_MMA(1, 1, At, B1); PG8_BAR;
            PG8_LDB(B0, 1, 0); PG8_SCHED; PG8_LDA(At, 1, 0); PG8_STAGEA(PG8_SA(0, 1), a2 + hstepA, voffA);
            PG8_WAIT_L(8); PG8_BAR; PG8_WAIT_L(0); PG8_MMA(0, 0, At, B0); PG8_BAR; PG8_SCHED;
            PG8_LDB(B1, 1, 1); PG8_STAGE(PG8_SB(1, 0), b3, voffB);
            PG8_BAR; PG8_WAIT_L(0); PG8_MMA(0, 1, At, B1); PG8_BAR;
            PG8_LDA(At, 1, 1); PG8_STAGEA(PG8_SA(1, 0), a3, voffA);
            PG8_BAR; PG8_WAIT_L(0); PG8_MMA(1, 0, At, B0); PG8_BAR; PG8_SCHED;
            PG8_STAGE(PG8_SB(1, 1), b3 + hstepB, voffB);
            PG8_WAIT_V(6); PG8_BAR; PG8_MMA(1, 1, At, B1); PG8_BAR;
            }
        }
        if constexpr (ALIGN_EPI) { if (wr == 0) PG8_BAR; }
        if constexpr (!Epi::AFTER_DRAIN) { E(acc, cur, wr, wc, fr, fq); S.done(cur); }
        if (!has_next) break;
        if (!(Epi::PAIRED && (ui & 1) == 0)) {
#pragma unroll
        for (int a = 0; a < 2; ++a)
#pragma unroll
            for (int b = 0; b < 2; ++b)
#pragma unroll
                for (int m = 0; m < 4; ++m)
#pragma unroll
                    for (int n = 0; n < 2; ++n) acc[a][b][m][n] = (f32x4){0.f, 0.f, 0.f, 0.f};
        }
        cur = nxt; cA = nA; cB = nB; ++ui;
        if constexpr (ALIGN_EPI) { if (wr == 1) PG8_BAR; }
    }
    PG8_WAIT_V(0);
    if constexpr (!ALIGN_EPI) { if (wr == 0) PG8_BAR; }
    PG8_BAR;
    if constexpr (Epi::AFTER_DRAIN) { E.fused(acc, cur, wr, wc, fr, fq, lds, wid, lane); S.done(cur); }
#undef PG8_SA
#undef PG8_SB
#undef PG8_STAGE
#undef PG8_STAGEA
#undef PG8_LDA
#undef PG8_LDB
#undef PG8_MMA
#undef PG8_WAIT_V
#undef PG8_WAIT_L
#undef PG8_BAR
#undef PG8_SCHED
}
}
#define LAS __attribute__((address_space(3)))
typedef unsigned short bf16_t;
typedef short bf16x8 __attribute__((ext_vector_type(8)));
typedef short s16x4 __attribute__((ext_vector_type(4)));
typedef float f32x4 __attribute__((ext_vector_type(4)));
typedef float f32x16 __attribute__((ext_vector_type(16)));
typedef unsigned u32x4 __attribute__((ext_vector_type(4)));
typedef unsigned u32x2 __attribute__((ext_vector_type(2)));

constexpr int NB = 16, SEQ = 2048, DM = 1024, FF = 2816, NIN = 4352, M = NB * SEQ;
constexpr int NWAVES = 8;
constexpr float EPS = 1e-6f, LOG2E = 1.4426950408889634f;
constexpr size_t MiB = 1u << 20;
constexpr size_t WS_WF1 = 1 * MiB, WS_WD1 = 12 * MiB, WS_WIN = 18 * MiB, WS_WPA = 27 * MiB, WS_WPB = 28 * MiB, WS_WOUT = 29 * MiB, WS_WF2 = 31 * MiB, WS_WD2 = 42 * MiB;
constexpr size_t WS_XN = 48 * MiB, WS_BIG = 112 * MiB, WS_OA = 384 * MiB, WS_OB = 416 * MiB, WS_SS1 = 448 * MiB, WS_SS2 = 450 * MiB, WS_END = 452 * MiB;
static_assert(WS_WD2 + (size_t)DM * FF * 2 <= WS_XN && WS_BIG + (size_t)M * NIN * 2 <= WS_OA, "d_ws map");
constexpr int RING_BYTES = 131072, LDS_BYTES = 147456, MISC_OFF = RING_BYTES + 256;
constexpr size_t WS_BAR = 0, BAR_ZERO_BYTES = 16384;

__device__ __forceinline__ float wave_sum(float v) {
#pragma unroll
    for (int o = 1; o < 64; o <<= 1) v += __shfl_xor(v, o);
    return v;
}
__device__ __forceinline__ unsigned f2bf(float f) { unsigned u = __builtin_bit_cast(unsigned, f); return (u + 0x7fffu + ((u >> 16) & 1u)) >> 16; }
__device__ __forceinline__ unsigned pk2(float lo, float hi) { return f2bf(lo) | (f2bf(hi) << 16); }

#define XB_TMO      128
#define XB_XCNT(j)  (256  + 64 * (j))
#define XB_XSUB(j)  (1280 + 64 * (j))
#define XB_XGEN(j)  (2304 + 64 * (j))
#define XB_TOP      3328
#define XB_TOPGEN   3392
#define XCD_BAR_WORDS 3456
#define XB_SPIN_CAP (1u << 18)

__device__ __forceinline__ unsigned xb_ld(unsigned* p)              { return __hip_atomic_load(p, __ATOMIC_RELAXED, __HIP_MEMORY_SCOPE_AGENT); }
__device__ __forceinline__ unsigned xb_add(unsigned* p, unsigned v) { return __hip_atomic_fetch_add(p, v, __ATOMIC_RELAXED, __HIP_MEMORY_SCOPE_AGENT); }
__device__ __forceinline__ unsigned xb_xcc_id() { return (unsigned)__builtin_amdgcn_s_getreg((3 << 11) | 20) & 0xFu; }
#define XB_SPIN(cond, bar) do { unsigned _sp = 0; while (cond) { __builtin_amdgcn_s_sleep(1); \
    if ((++_sp & 255u) == 0u) { if (xb_ld(&(bar)[XB_TMO])) break; if (_sp > XB_SPIN_CAP) { atomicAdd(&(bar)[XB_TMO], 1u); break; } } } } while (0)

struct XcdBarrier {
    unsigned* bar; unsigned x;
    volatile LAS unsigned* st;
};

__device__ __forceinline__ XcdBarrier xcd_barrier_post(unsigned* bar, volatile LAS unsigned* st) {
    XcdBarrier b; b.bar = bar; b.x = xb_xcc_id(); b.st = st;
    if (threadIdx.x == 0) (void)xb_add(&bar[XB_XCNT(b.x)], 1u);
    return b;
}
__device__ __forceinline__ void xcd_barrier_complete(unsigned* bar, unsigned x, unsigned& nloc, unsigned& nx) {
    const unsigned G = gridDim.x * gridDim.y * gridDim.z;
    unsigned sum, cnt, mine, sp = 0u;
    for (;;) {
        sum = 0u; cnt = 0u; mine = 0u;
#pragma unroll
        for (unsigned j = 0; j < 16; ++j) { const unsigned c = xb_ld(&bar[XB_XCNT(j)]); sum += c; cnt += (c > 0u) ? 1u : 0u; mine = (j == x) ? c : mine; }
        if (sum == G) break;
        __builtin_amdgcn_s_sleep(1);
        if ((++sp & 255u) == 0u) { if (xb_ld(&bar[XB_TMO])) break; if (sp > XB_SPIN_CAP) { atomicAdd(&bar[XB_TMO], 1u); break; } }
    }
    nloc = mine > 0u ? mine : 1u; nx = cnt > 0u ? cnt : 1u;
}

__device__ __forceinline__ void xcd_barrier(const XcdBarrier& b) {
    asm volatile("s_waitcnt vmcnt(0)" ::: "memory");
    __syncthreads();
    if (threadIdx.x == 0) {
        unsigned* bar = b.bar;
        __builtin_amdgcn_s_waitcnt(0);
        unsigned nloc = b.st[0], nx = b.st[1];
        if (nloc == 0u) { xcd_barrier_complete(bar, b.x, nloc, nx); b.st[0] = nloc; b.st[1] = nx; }
        const unsigned old = xb_add(&bar[XB_XSUB(b.x)], 1u);
        const unsigned gen = old / nloc;
        if (old + 1u == (gen + 1u) * nloc) {
            __builtin_amdgcn_fence(__ATOMIC_RELEASE, "agent");
            asm volatile("s_waitcnt vmcnt(0)" ::: "memory");
            const unsigned og = xb_add(&bar[XB_TOP], 1u);
            const unsigned tg = og / nx;
            if (og + 1u == (tg + 1u) * nx) xb_add(&bar[XB_TOPGEN], 1u);
            else XB_SPIN(xb_ld(&bar[XB_TOPGEN]) == tg, bar);
            __builtin_amdgcn_fence(__ATOMIC_ACQUIRE, "agent");
            xb_add(&bar[XB_XGEN(b.x)], 1u);
            asm volatile("s_waitcnt vmcnt(0)" ::: "memory");
        } else {
            XB_SPIN(xb_ld(&bar[XB_XGEN(b.x)]) == gen, bar);
            __builtin_amdgcn_fence(__ATOMIC_ACQUIRE, "agent");
            asm volatile("s_waitcnt vmcnt(0)" ::: "memory");
        }
    }
    __syncthreads();
}

__device__ __forceinline__ void transpose_item(const float* W, int K, int N, bf16_t* WT, int ilv, const float* gain, LAS float* scr, int item, int lane) {
    const int nblk = N / 32, kb = item / nblk, nb = item % nblk, k0 = 64 * kb, n0 = 32 * nb;
    int rbase = n0; const int il = ilv & 7;
    if (il == 1 || il == 2) rbase = (n0 >> 7) * 256 + (n0 & 127) + (il == 2 ? 128 : 0);
    else if (il == 3 && n0 >= 2304) { const int jg = (n0 - 2304) & 1023; rbase = 2304 + (jg >> 7) * 256 + (jg & 127) + (n0 >= 3328 ? 128 : 0); }
#pragma unroll
    for (int i = 0; i < 32; ++i) { const int kk = 2 * i + (lane >> 5); const float gk = gain ? gain[k0 + kk] : 1.0f; scr[kk * 33 + (lane & 31)] = W[(size_t)(k0 + kk) * N + n0 + (lane & 31)] * gk; }
    asm volatile("s_waitcnt lgkmcnt(0)" ::: "memory");
    const int c = lane & 7;
#pragma unroll
    for (int j = 0; j < 4; ++j) { const int n = (lane >> 3) + 8 * j; const LAS float* s = scr + (8 * c) * 33 + n;
        u32x4 o; o.x = pk2(s[0 * 33], s[1 * 33]); o.y = pk2(s[2 * 33], s[3 * 33]); o.z = pk2(s[4 * 33], s[5 * 33]); o.w = pk2(s[6 * 33], s[7 * 33]);
        const int rown = rbase + n;
        bf16_t* dst = (ilv & 8) ? WT + ((size_t)((rown >> 8) * (K >> 6) + (k0 >> 6)) * 256 + (rown & 255)) * 64 + 8 * c : WT + (size_t)rown * K + k0 + 8 * c;
        *(u32x4*)dst = o; }
    asm volatile("s_waitcnt lgkmcnt(0)" ::: "memory");
}
__device__ __forceinline__ void rms_rows2_bf16(const float* xrow, bf16_t* XNb, size_t row, int lane) {
    const f32x4* xr = (const f32x4*)xrow + lane;
    f32x4 v[2][4]; float s[2] = {0.f, 0.f};
#pragma unroll
    for (int q = 0; q < 2; ++q)
#pragma unroll
        for (int j = 0; j < 4; ++j) v[q][j] = __builtin_nontemporal_load(xr + q * 256 + 64 * j);
#pragma unroll
    for (int q = 0; q < 2; ++q)
#pragma unroll
        for (int j = 0; j < 4; ++j) s[q] += (v[q][j].x * v[q][j].x + v[q][j].y * v[q][j].y) + (v[q][j].z * v[q][j].z + v[q][j].w * v[q][j].w);
#pragma unroll
    for (int q = 0; q < 2; ++q) {
        const float rstd = 1.0f / sqrtf(wave_sum(s[q]) * (1.0f / DM) + EPS);
#pragma unroll
        for (int j = 0; j < 4; ++j) { u32x2 w; w.x = pk2(v[q][j].x * rstd, v[q][j].y * rstd); w.y = pk2(v[q][j].z * rstd, v[q][j].w * rstd);
            *(u32x2*)(XNb + pg8::tix(row + q, 4 * lane + 256 * j, 16, XN_TILED)) = w; }
    }
}
__device__ __forceinline__ float bfl(unsigned w) { return __uint_as_float(w << 16); }
__device__ __forceinline__ float bfh(unsigned w) { return __uint_as_float(w & 0xffff0000u); }
__device__ __forceinline__ void final_rows2(const bf16_t* XNb, const float* SS, size_t row, const float* g, float* orow, int lane) {
    u32x4 t[2][2];
#pragma unroll
    for (int q = 0; q < 2; ++q)
#pragma unroll
        for (int hf = 0; hf < 2; ++hf) t[q][hf] = *(const u32x4*)(XNb + pg8::tix(row + q, hf * 512 + 8 * lane, 16, XN_TILED));
    f32x4 gv[2][2];
#pragma unroll
    for (int hf = 0; hf < 2; ++hf) { gv[hf][0] = *(const f32x4*)(g + hf * 512 + 8 * lane); gv[hf][1] = *(const f32x4*)(g + hf * 512 + 8 * lane + 4); }
#pragma unroll
    for (int q = 0; q < 2; ++q) {
        const f32x4* p = (const f32x4*)(SS + (row + q) * 16);
        const f32x4 a = p[0], b2 = p[1], c = p[2], d = p[3];
        const float s = ((a[0] + a[1]) + (a[2] + a[3])) + ((b2[0] + b2[1]) + (b2[2] + b2[3])) + ((c[0] + c[1]) + (c[2] + c[3])) + ((d[0] + d[1]) + (d[2] + d[3]));
        const float rstd = 1.0f / sqrtf(s * (1.0f / DM) + EPS);
#pragma unroll
        for (int hf = 0; hf < 2; ++hf) {
            const u32x4 w = t[q][hf];
            const f32x4 v0 = (f32x4){bfl(w.x), bfh(w.x), bfl(w.y), bfh(w.y)}, v1 = (f32x4){bfl(w.z), bfh(w.z), bfl(w.w), bfh(w.w)};
            float* o = orow + q * 1024 + hf * 512 + 8 * lane;
            __builtin_nontemporal_store(v0 * rstd * gv[hf][0], (f32x4*)o); __builtin_nontemporal_store(v1 * rstd * gv[hf][1], (f32x4*)(o + 4));
        }
    }
}

__device__ __forceinline__ int crow(int r, int hi) { return (r & 3) + 8 * (r >> 2) + 4 * hi; }
typedef float f32x2_t __attribute__((ext_vector_type(2))); typedef __bf16 bf16x2_t __attribute__((ext_vector_type(2)));
__device__ __forceinline__ unsigned cvtpk(float lo, float hi) { f32x2_t v = {lo, hi}; bf16x2_t b = __builtin_convertvector(v, bf16x2_t); return __builtin_bit_cast(unsigned, b); }
constexpr int VT_PITCH = 72, TAB_OFF = 64 * VT_PITCH;

__device__ __forceinline__ float xmax32(float v) {
    auto rr = __builtin_amdgcn_permlane32_swap(__float_as_uint(v), __float_as_uint(v), false, false);
    return __builtin_fmaxf(__uint_as_float(rr[0]), __uint_as_float(rr[1]));
}
typedef short v4i16_t __attribute__((ext_vector_type(4)));
constexpr float RESC_THR = 8.0f;
constexpr int KS_PITCH = 144, ATT_VT = 64 * KS_PITCH, ATT_BUF = 2 * 64 * KS_PITCH, ATT_TAB = 2 * ATT_BUF;
__device__ __forceinline__ void attn_first_ptrs(const bf16_t* PROJ, bool isB, int b, int hx, int cx, int tid, int lane, int wave, const bf16_t*& kp, const bf16_t*& vp, const bf16_t*& qp) {
    const int nprev = isB ? 2 : 8, j0 = cx < nprev ? nprev - cx : 0;
    const long srow = (long)b * SEQ + (cx - nprev + j0) * 64 + (tid >> 3);
    const bf16_t* base = PROJ + (size_t)srow * pg8::PROJ_LD + 8 * (tid & 7);
    kp = base + (isB ? 2048 + hx * 64 : 512 + hx * 64); vp = base + (isB ? 2176 + hx * 64 : 1024 + hx * 64);
    const int h = isB ? 4 * hx + (wave >> 1) : hx, cq = isB ? cx : cx + (wave >> 1);
    qp = PROJ + ((size_t)b * SEQ + cq * 64 + (wave & 1) * 32 + (lane & 31)) * pg8::PROJ_LD + (isB ? 1536 : 0) + h * 64 + 8 * (lane >> 5);
}
struct AttnNext { bool valid, isB; int b, hx, cx; };
template <bool IS_B>
__device__ __forceinline__ void attn_wg_unit(const bf16_t* __restrict__ PROJ, bf16_t* __restrict__ Oout, int b, int hx, int cx, LAS unsigned char* lds,
                                             const float* __restrict__ rel_bias, const float* __restrict__ sinks, int tid, int lane, int wave,
                                             bf16x8& kreg, bf16x8& vreg, bf16x8 (&qf)[4], const AttnNext nx) {
    constexpr int NPREV = IS_B ? 2 : 8, PP = pg8::PROJ_LD, NT = IS_B ? 3 : 12;
    const int r = lane & 31, hi = lane >> 5;
    const int ci = IS_B ? 0 : (wave >> 1), qh = wave & 1;
    const int h = IS_B ? 4 * hx + (wave >> 1) : hx;
    const int cq = cx + ci;
    const int qcol = IS_B ? 1536 + h * 64 : h * 64;
    const int kcol = IS_B ? 2048 + hx * 64 : 512 + hx * 64;
    const int vcol = IS_B ? 2176 + hx * 64 : 1024 + hx * 64;
    const size_t tok0 = (size_t)b * SEQ;
    const int j0 = cx < NPREV ? NPREV - cx : 0;
    const int srow = tid >> 3, sch = tid & 7;
    const long srow0 = (long)tok0 + (cx - NPREV) * 64 + srow;
#define ATT_SRC(j, col) (PROJ + (size_t)(srow0 + (long)(j) * 64) * PP + 8 * sch + (col))
    bf16x8 qn[4];
    const bf16_t *nkp = nullptr, *nvp = nullptr, *nqp = nullptr;
    if (nx.valid) attn_first_ptrs(PROJ, nx.isB, nx.b, nx.hx, nx.cx, tid, lane, wave, nkp, nvp, nqp);
    const LAS float* tab = (const LAS float*)(lds + ATT_TAB) + (IS_B ? 0 : h * 192);
    float m, l, slope2 = 0.f;
    if (IS_B) { m = ((const LAS float*)(lds + ATT_TAB))[8 * 192 + h]; l = hi == 0 ? 1.f : 0.f; slope2 = LOG2E * __builtin_amdgcn_exp2f(-(float)(h + 1)); }
    else { m = -1e30f; l = 0.f; }
    f32x16 o[2];
#pragma unroll
    for (int d = 0; d < 2; ++d)
#pragma unroll
        for (int i = 0; i < 16; ++i) o[d][i] = 0.f;
    for (int j = j0; j < NT; ++j) {
        LAS unsigned char* buf = lds + (j & 1) * ATT_BUF;
        *(LAS bf16x8*)(buf + srow * KS_PITCH + sch * 16) = kreg;
        *(LAS bf16x8*)(buf + ATT_VT + srow * KS_PITCH + sch * 16) = vreg;
        if (j + 1 < NT) { kreg = *(const bf16x8*)ATT_SRC(j + 1, kcol); vreg = *(const bf16x8*)ATT_SRC(j + 1, vcol); }
        else if (nx.valid) {
            kreg = *(const bf16x8*)nkp; vreg = *(const bf16x8*)nvp;
#pragma unroll
            for (int s = 0; s < 4; ++s) qn[s] = *(const bf16x8*)(nqp + 16 * s);
        }
        asm volatile("s_waitcnt lgkmcnt(0)" ::: "memory"); __builtin_amdgcn_s_barrier(); asm volatile("" ::: "memory");
        const int dc = IS_B ? NPREV - j : ci + NPREV - j;
        if (IS_B || (dc >= 0 && dc <= NPREV)) {
            f32x16 sv[2];
#pragma unroll
            for (int kh = 0; kh < 2; ++kh) {
#pragma unroll
                for (int i = 0; i < 16; ++i) sv[kh][i] = 0.f;
#pragma unroll
                for (int st = 0; st < 4; ++st) {
                    const bf16x8 kfr = *(const LAS bf16x8*)(buf + (32 * kh + r) * KS_PITCH + (16 * st + 8 * hi) * 2);
                    sv[kh] = __builtin_amdgcn_mfma_f32_32x32x16_bf16(kfr, qf[st], sv[kh], 0, 0, 0);
                }
            }
            const bool cbias = !IS_B && dc >= 3;
            const float cb = cbias ? tab[191] : 0.f;
            const int relq = 64 * dc + 32 * qh + r - 4 * hi;
            if (IS_B) {
                const float rf = (float)relq;
#pragma unroll
                for (int kh = 0; kh < 2; ++kh)
#pragma unroll
                    for (int i = 0; i < 16; ++i) sv[kh][i] -= slope2 * __builtin_fabsf(rf - (float)(32 * kh + (i & 3) + 8 * (i >> 2)));
            } else if (!cbias) {
#pragma unroll
                for (int kh = 0; kh < 2; ++kh)
#pragma unroll
                    for (int i = 0; i < 16; ++i) { int rel = relq - (32 * kh + (i & 3) + 8 * (i >> 2)); rel = rel > 128 ? 128 : rel; sv[kh][i] += tab[rel + 63]; }
            }
            float t0 = sv[0][0], t1 = sv[1][0];
#pragma unroll
            for (int i = 1; i < 16; i += 3) { t0 = __builtin_fmaxf(__builtin_fmaxf(t0, sv[0][i]), sv[0][i + 1]); t0 = __builtin_fmaxf(t0, sv[0][i + 2]); t1 = __builtin_fmaxf(__builtin_fmaxf(t1, sv[1][i]), sv[1][i + 1]); t1 = __builtin_fmaxf(t1, sv[1][i + 2]); }
            const float tm = xmax32(__builtin_fmaxf(t0, t1)) + cb;
            if (__any(tm > m + RESC_THR)) {
                const float mn = __builtin_fmaxf(m, tm);
                const float alpha = __builtin_amdgcn_exp2f(m - mn);
                m = mn; l *= alpha;
#pragma unroll
                for (int d = 0; d < 2; ++d)
#pragma unroll
                    for (int i = 0; i < 16; ++i) o[d][i] *= alpha;
            }
            const float off = m - cb;
            float ps0 = 0.f, ps1 = 0.f;
#pragma unroll
            for (int i = 0; i < 16; ++i) { sv[0][i] = __builtin_amdgcn_exp2f(sv[0][i] - off); sv[1][i] = __builtin_amdgcn_exp2f(sv[1][i] - off); ps0 += sv[0][i]; ps1 += sv[1][i]; }
            l += ps0 + ps1;
            bf16x8 pk[4];
#pragma unroll
            for (int ks = 0; ks < 4; ++ks) {
                const f32x16& s = sv[ks >> 1]; const int q0 = 8 * (ks & 1);
                u32x4 w; w.x = cvtpk(s[q0], s[q0 + 1]); w.y = cvtpk(s[q0 + 2], s[q0 + 3]); w.z = cvtpk(s[q0 + 4], s[q0 + 5]); w.w = cvtpk(s[q0 + 6], s[q0 + 7]);
                pk[ks] = __builtin_bit_cast(bf16x8, w);
            }
#pragma unroll
            for (int d = 0; d < 2; ++d)
#pragma unroll
                for (int ks = 0; ks < 4; ++ks) {
                    const LAS unsigned char* vb = buf + ATT_VT + (16 * ks + 4 * hi + ((lane & 15) >> 2)) * KS_PITCH + (32 * d + 16 * ((lane >> 4) & 1) + 4 * (lane & 3)) * 2;
                    const s16x4 lo = __builtin_bit_cast(s16x4, __builtin_amdgcn_ds_read_tr16_b64_v4i16((LAS v4i16_t*)vb));
                    const s16x4 hv = __builtin_bit_cast(s16x4, __builtin_amdgcn_ds_read_tr16_b64_v4i16((LAS v4i16_t*)(vb + 8 * KS_PITCH)));
                    const bf16x8 va = __builtin_shufflevector(lo, hv, 0, 1, 2, 3, 4, 5, 6, 7);
                    o[d] = __builtin_amdgcn_mfma_f32_32x32x16_bf16(va, pk[ks], o[d], 0, 0, 0);
                }
        }
    }
    {
        const float lt = l + __shfl_xor(l, 32);
        const float inv = 1.0f / lt;
        bf16_t* op = Oout + pg8::tix(tok0 + cq * 64 + qh * 32 + r, h * 64 + 4 * hi, 8, O_TILED);
#pragma unroll
        for (int d = 0; d < 2; ++d)
#pragma unroll
            for (int g = 0; g < 4; ++g) {
                u32x2 w; w.x = cvtpk(o[d][4 * g] * inv, o[d][4 * g + 1] * inv); w.y = cvtpk(o[d][4 * g + 2] * inv, o[d][4 * g + 3] * inv);
                *(u32x2*)(op + 32 * d + 8 * g) = w;
            }
    }
#undef ATT_SRC
    if (nx.valid) {
#pragma unroll
        for (int s = 0; s < 4; ++s) qf[s] = qn[s];
    }
    asm volatile("s_waitcnt lgkmcnt(0)" ::: "memory"); __builtin_amdgcn_s_barrier(); asm volatile("" ::: "memory");
}
struct Args { const float* in[17]; float* out; unsigned char* ws; };
enum { I_X = 0, I_N1, I_G1, I_U1, I_D1, I_NM, I_WIN, I_RELB, I_SINK, I_WPA, I_WPB, I_WOUT, I_N2, I_G2, I_U2, I_D2, I_NF };


#define PREP_ROWSCALE(rs_, S_, SS_) do { \
        pg8::Unit u_; int pmA_ = -1, pmB_ = -1; bool multi_ = false; \
        for (int i_ = 0; (S_).next(i_, u_); ++i_) { if (pmA_ < 0) pmA_ = u_.pm; else if (u_.pm != pmA_) { if (pmB_ < 0) pmB_ = u_.pm; else if (u_.pm != pmB_) multi_ = true; } } \
        if (pmB_ < 0) pmB_ = pmA_; \
        LAS float* tab_ = (LAS float*)(lds + RING_BYTES + 1024); \
        (rs_).SS = (SS_); (rs_).pmA = pmA_; (rs_).tab = (multi_ || pmA_ < 0) ? nullptr : tab_; \
        if ((rs_).tab) { const size_t row_ = (size_t)((tid < 256) ? pmA_ : pmB_) * 256 + (tid & 255); tab_[tid] = pg8::row_rstd((SS_), row_); } \
        __syncthreads(); } while (0)
__global__ void __launch_bounds__(NWAVES * 64, 2) mega_fwd(Args a) {
    extern __shared__ __attribute__((aligned(16))) unsigned char lds_raw[];
    LAS unsigned char* lds = (LAS unsigned char*)lds_raw;
    cg::grid_group grid = cg::this_grid();
    const int tid = threadIdx.x, lane = tid & 63, wave = __builtin_amdgcn_readfirstlane(tid >> 6);
    const int G = gridDim.x, bx = blockIdx.x;
    const int gw = bx * NWAVES + wave, NGW = G * NWAVES;
    unsigned char* ws = a.ws;
    bf16_t* WF1 = (bf16_t*)(ws + WS_WF1); bf16_t* WD1 = (bf16_t*)(ws + WS_WD1); bf16_t* WIN = (bf16_t*)(ws + WS_WIN); bf16_t* WPA = (bf16_t*)(ws + WS_WPA);
    bf16_t* WPB = (bf16_t*)(ws + WS_WPB); bf16_t* WOUT = (bf16_t*)(ws + WS_WOUT); bf16_t* WF2 = (bf16_t*)(ws + WS_WF2); bf16_t* WD2 = (bf16_t*)(ws + WS_WD2);
    bf16_t* XN = (bf16_t*)(ws + WS_XN); bf16_t* BIG = (bf16_t*)(ws + WS_BIG); bf16_t* OA = (bf16_t*)(ws + WS_OA); bf16_t* OB = (bf16_t*)(ws + WS_OB);
    float* X = a.out;
    volatile LAS unsigned* MISC = (volatile LAS unsigned*)(lds + MISC_OFF);
    if (tid < 16) MISC[tid] = 0u;
    __syncthreads();
    XcdBarrier bar = xcd_barrier_post((unsigned*)(ws + WS_BAR), MISC + 8);
#define GRID_BAR() xcd_barrier(bar)

    float* SS1 = (float*)(ws + WS_SS1); float* SS2 = (float*)(ws + WS_SS2);
    bf16_t* T = (bf16_t*)a.out;
    {
        LAS float* scr = (LAS float*)(lds + wave * 16384);
        constexpr int I_FF = (DM / 64) * (FF / 32), I_DN = (FF / 64) * (DM / 32), I_IN = (DM / 64) * (NIN / 32);
        constexpr int NITEMS = 2 * I_FF + I_DN + I_IN;
        for (int it = gw; it < NITEMS; it += NGW) {
            int r = it;
            if (r < I_FF) { transpose_item(a.in[I_G1], DM, FF, WF1, 1 | 8, a.in[I_N1], scr, r, lane); continue; } r -= I_FF;
            if (r < I_FF) { transpose_item(a.in[I_U1], DM, FF, WF1, 2 | 8, a.in[I_N1], scr, r, lane); continue; } r -= I_FF;
            if (r < I_DN) { transpose_item(a.in[I_D1], FF, DM, WD1, 8, nullptr, scr, r, lane); continue; } r -= I_DN;
            transpose_item(a.in[I_WIN], DM, NIN, WIN, 3 | 8, a.in[I_NM], scr, r, lane);
        }
        for (int mrow = 2 * gw; mrow < M; mrow += 2 * NGW) rms_rows2_bf16(a.in[I_X] + (size_t)mrow * DM, XN, (size_t)mrow, lane);
    }
    if (a.ws == nullptr) grid.sync();
    GRID_BAR();
    { pg8::Gemm g{XN, WF1, M, 2 * FF, DM, XN_TILED, 1}; pg8::StaticOrder S; S.init(M, 2 * FF, G, bx); pg8::EpiSwiglu<false> E{BIG, FF, pg8::RowScale{nullptr, nullptr, 0}};
      pg8::gemm_phase<pg8::EpiSwiglu<false>, pg8::StaticOrder, true, true>(lds, g, S, E);
      DUP(1) pg8::gemm_phase<pg8::EpiSwiglu<false>, pg8::StaticOrder, true, true>(lds, g, S, E); }
    GRID_BAR();
    DUP(20) { GRID_BAR(); GRID_BAR(); GRID_BAR(); GRID_BAR(); GRID_BAR(); GRID_BAR(); GRID_BAR(); GRID_BAR(); }
    { pg8::Gemm g{BIG, WD1, M, DM, FF, 1, 1}; pg8::StaticOrder S; S.init(M, DM, G, bx); pg8::EpiResidB<true> E{a.in[I_X], XN, 0.5f, SS1};
      pg8::gemm_phase<pg8::EpiResidB<true>, pg8::StaticOrder, true, false>(lds, g, S, E);
      DUP(2) pg8::gemm_phase<pg8::EpiResidB<true>, pg8::StaticOrder, true, true>(lds, g, S, E); }
    GRID_BAR();
    { pg8::Gemm g{XN, WIN, M, NIN, DM, XN_TILED, 1}; pg8::StaticOrder S; S.init(M, NIN, G, bx); pg8::RowScale RS; PREP_ROWSCALE(RS, S, SS1); pg8::EpiProjIn E{BIG, BIG + (size_t)M * pg8::PROJ_LD, RS};
      pg8::gemm_phase<pg8::EpiProjIn, pg8::StaticOrder, true, true>(lds, g, S, E);
      DUP(4) pg8::gemm_phase<pg8::EpiProjIn, pg8::StaticOrder, true, true>(lds, g, S, E); }
    {
        constexpr int NU4 = (M / 256) * (NIN / 256);
        const int rounds = (NU4 + G - 1) / G, nbusy = NU4 - (rounds - 1) * G;
        const int nidle = G - nbusy;
        const bool all = (nidle <= 0);
        if (all || bx >= nbusy) {
            int t4 = threadIdx.x; asm volatile("" : "+v"(t4)); const int lane = t4 & 63, wave = __builtin_amdgcn_readfirstlane(t4 >> 6), gw = bx * NWAVES + wave;
            LAS float* scr = (LAS float*)(lds + wave * 16384);
            constexpr int I_FF = (DM / 64) * (FF / 32), I_DN = (FF / 64) * (DM / 32), I_P = (512 / 64) * (DM / 32), I_O = (DM / 64) * (DM / 32);
            constexpr int NLATE = 2 * I_P + I_O + 2 * I_FF + I_DN;
            const int w0 = all ? gw : (bx - nbusy) * NWAVES + wave, nw = all ? NGW : nidle * NWAVES;
            for (int it = w0; it < NLATE; it += nw) {
                int r = it;
                if (r < I_P) { transpose_item(a.in[I_WPA], 512, DM, WPA, 8, nullptr, scr, r, lane); continue; } r -= I_P;
                if (r < I_P) { transpose_item(a.in[I_WPB], 512, DM, WPB, 8, nullptr, scr, r, lane); continue; } r -= I_P;
                if (r < I_O) { transpose_item(a.in[I_WOUT], DM, DM, WOUT, 8, nullptr, scr, r, lane); continue; } r -= I_O;
                if (r < I_FF) { transpose_item(a.in[I_G2], DM, FF, WF2, 1 | 8, a.in[I_N2], scr, r, lane); continue; } r -= I_FF;
                if (r < I_FF) { transpose_item(a.in[I_U2], DM, FF, WF2, 2 | 8, a.in[I_N2], scr, r, lane); continue; } r -= I_FF;
                transpose_item(a.in[I_D2], FF, DM, WD2, 8, nullptr, scr, r, lane);
            }
        }
    }
    GRID_BAR();
    {
        const int vcu = (G % 8 == 0) ? (bx % 8) * (G / 8) + bx / 8 : bx;
        int tid5_ = threadIdx.x; asm volatile("" : "+v"(tid5_));
        const int tid = tid5_, lane = tid & 63, wave = __builtin_amdgcn_readfirstlane(tid >> 6);
#define ATT_DESC(u_, d_) do { const int uu_ = (u_); (d_).valid = uu_ < 2048; (d_).isB = uu_ >= 1024; \
            if (uu_ < 1024) { const int i_ = uu_ >> 8, w_ = uu_ & 255; (d_).b = (w_ >> 6) + 4 * i_; (d_).hx = (w_ >> 3) & 7; (d_).cx = 4 * (((w_ & 7) + 2 * i_) & 7); } \
            else { const int v_ = uu_ - 1024; (d_).b = v_ >> 6; (d_).hx = (v_ >> 5) & 1; (d_).cx = v_ & 31; } } while (0)
        {
            LAS float* tabs = (LAS float*)(lds + ATT_TAB);
            for (int i = tid; i < 8 * 192; i += NWAVES * 64) tabs[i] = a.in[I_RELB][i] * LOG2E;
            if (tid < 8) tabs[8 * 192 + tid] = a.in[I_SINK][tid] * LOG2E;
            __syncthreads();
        }
        for (int rep = 0; rep < (PROBE_DUP == 5 ? 2 : 1); ++rep) {
        AttnNext cur; ATT_DESC(vcu, cur);
        bf16x8 kreg, vreg, qf[4];
        if (cur.valid) { const bf16_t *kp, *vp, *qp; attn_first_ptrs(BIG, cur.isB, cur.b, cur.hx, cur.cx, tid, lane, wave, kp, vp, qp);
            kreg = *(const bf16x8*)kp; vreg = *(const bf16x8*)vp;
#pragma unroll
            for (int s = 0; s < 4; ++s) qf[s] = *(const bf16x8*)(qp + 16 * s); }
        for (int u = vcu; u < 2048; u += G) {
            AttnNext nx; ATT_DESC(u + G, nx);
            if (!cur.isB) attn_wg_unit<false>(BIG, OA, cur.b, cur.hx, cur.cx, lds, a.in[I_RELB], a.in[I_SINK], tid, lane, wave, kreg, vreg, qf, nx);
            else attn_wg_unit<true>(BIG, OB, cur.b, cur.hx, cur.cx, lds, a.in[I_RELB], a.in[I_SINK], tid, lane, wave, kreg, vreg, qf, nx);
            cur = nx;
        }
        }
#undef ATT_DESC
    }
    GRID_BAR();
    { pg8::Gemm g{OA, WPA, 2 * M, 2 * DM, 512, O_TILED, 1}; pg8::PairOrder S; S.init(M, DM, G, bx); pg8::EpiGatePair E{BIG + (size_t)M * pg8::PROJ_LD, T};
      pg8::gemm_phase<pg8::EpiGatePair, pg8::PairOrder, true, true>(lds, g, S, E);
      DUP(6) pg8::gemm_phase<pg8::EpiGatePair, pg8::PairOrder, true, true>(lds, g, S, E); }
    GRID_BAR();
    { pg8::Gemm g{T, WOUT, M, DM, DM, T_TILED, 1}; pg8::StaticOrder S; S.init(M, DM, G, bx); pg8::EpiResidB<false> E{XN, XN, 1.0f, SS2};
      pg8::gemm_phase<pg8::EpiResidB<false>, pg8::StaticOrder, true, true>(lds, g, S, E); }
    GRID_BAR();
    { pg8::Gemm g{XN, WF2, M, 2 * FF, DM, XN_TILED, 1}; pg8::StaticOrder S; S.init(M, 2 * FF, G, bx); pg8::RowScale RS; PREP_ROWSCALE(RS, S, SS2); pg8::EpiSwiglu<true> E{BIG, FF, RS};
      pg8::gemm_phase<pg8::EpiSwiglu<true>, pg8::StaticOrder, true, true>(lds, g, S, E);
      DUP(9) pg8::gemm_phase<pg8::EpiSwiglu<true>, pg8::StaticOrder, true, true>(lds, g, S, E); }
    GRID_BAR();
    { pg8::Gemm g{BIG, WD2, M, DM, FF, 1, 1}; pg8::StaticOrder S; S.init(M, DM, G, bx); pg8::EpiResidB<false> E{XN, XN, 0.5f, SS1};
      pg8::gemm_phase<pg8::EpiResidB<false>, pg8::StaticOrder, true, true>(lds, g, S, E); }
    GRID_BAR();
    { int t11 = threadIdx.x; asm volatile("" : "+v"(t11));
      const int lane11 = t11 & 63, gw11 = bx * NWAVES + __builtin_amdgcn_readfirstlane(t11 >> 6);
      for (int mrow = 2 * gw11; mrow < M; mrow += 2 * NGW) final_rows2(XN, SS1, (size_t)mrow, a.in[I_NF], X + (size_t)mrow * DM, lane11); }
}

extern "C" void kernel_launch(void* const* d_in, const int* in_sizes, int n_in, void* d_out, int out_size, void* d_ws, size_t ws_size, hipStream_t stream) {
    static int grid = 0;
    if (grid == 0) {
        if (n_in != 17 || in_sizes[0] != M * DM || out_size != M * DM || ws_size < WS_END) { fprintf(stderr, "kernel_launch: unexpected shapes (n_in %d, in0 %d, out %d, ws %zu)\n", n_in, n_in > 0 ? in_sizes[0] : -1, out_size, ws_size); grid = -1; return; }
        int dev = 0, cus = 0, per_cu = 0;
        (void)hipGetDevice(&dev);
        (void)hipDeviceGetAttribute(&cus, hipDeviceAttributeMultiprocessorCount, dev);
        if (hipFuncSetAttribute((const void*)mega_fwd, hipFuncAttributeMaxDynamicSharedMemorySize, LDS_BYTES) != hipSuccess) { fprintf(stderr, "kernel_launch: hipFuncSetAttribute failed\n"); grid = -1; return; }
        if (hipOccupancyMaxActiveBlocksPerMultiprocessor(&per_cu, (const void*)mega_fwd, NWAVES * 64, LDS_BYTES) != hipSuccess || per_cu < 1) { fprintf(stderr, "kernel_launch: occupancy query says %d\n", per_cu); per_cu = 1; }
        (void)hipGetLastError();
        grid = cus * 1;
        fprintf(stderr, "kernel_launch: grid %d (cus %d, per_cu %d)\n", grid, cus, per_cu);
    }
    if (grid < 0) return;
    if (hipMemsetAsync((char*)d_ws + WS_BAR, 0, BAR_ZERO_BYTES, stream) != hipSuccess) { fprintf(stderr, "kernel_launch: memset failed\n"); return; }
    Args a{};
    for (int i = 0; i < 17; ++i) a.in[i] = (const float*)d_in[i];
    a.out = (float*)d_out; a.ws = (unsigned char*)d_ws;
    void* args[] = {&a};
    hipError_t e = hipLaunchCooperativeKernel((const void*)mega_fwd, dim3(grid), dim3(NWAVES * 64), args, LDS_BYTES, stream);
    if (e != hipSuccess) fprintf(stderr, "kernel_launch: cooperative launch failed: %s (grid %d)\n", hipGetErrorString(e), grid);
}
```

```cpp
#include <hip/hip_runtime.h>
#include <hip/hip_cooperative_groups.h>
#include <cstdio>
#include <cstdint>
namespace cg = cooperative_groups;
#define XN_TILED 0
#define T_TILED 0
#define O_TILED 0
#ifndef PROBE_DUP
#define PROBE_DUP -1
#endif
#define DUP(k) if constexpr (PROBE_DUP == (k))
namespace pg8 {
#define PG8_LAS __attribute__((address_space(3)))
typedef unsigned short bf16_t;
typedef short bf16x8 __attribute__((ext_vector_type(8)));
typedef float f32x4 __attribute__((ext_vector_type(4)));
typedef unsigned u32x4 __attribute__((ext_vector_type(4)));
constexpr int BM = 256, BK = 64, HALF = 128, HTB = HALF * BK * 2  , STAGE_BYTES = 8 * HTB, NXCD = 8, WGM = 8;

__host__ __device__ __forceinline__ int lds_byte(int r, int c) { const int st = (r >> 4) * 2 + (c >> 5), rr = r & 15, cc = c & 31, ob = rr * 64 + cc * 2; return st * 1024 + (ob ^ (((ob >> 9) & 1) << 5)); }
__host__ __device__ __forceinline__ void stage_rc(int b, int& R, int& C) { const int st = b / 1024, sb = b % 1024, swz = sb ^ (((sb >> 9) & 1) << 5); R = (st >> 1) * 16 + swz / 64; C = (st & 1) * 32 + (swz % 64) / 2; }
__host__ __device__ __forceinline__ int perm32(int rho) { const int n = rho >> 4, i = rho & 15; return 8 * (i >> 2) + 4 * n + (i & 3); }

struct Unit { int pm, pn; };
struct Gemm { const bf16_t* A; const bf16_t* Bt; int M, N, K; int tiledA, tiledB; };

struct StaticOrder {
    int nM, nN, nwg, G, c;
    __host__ __device__ void init(int M, int N, int G_, int c_) { nM = M / BM; nN = N / BM; nwg = nM * nN; G = G_; c = c_; }
    __host__ __device__ bool next(int i, Unit& u) const {
        const long L = (long)i * G + c; if (L >= nwg) return false;
        int wgid = (int)L; { const int q = nwg / NXCD, r = nwg % NXCD, xcd = wgid % NXCD, off = wgid / NXCD; wgid = (xcd < r ? xcd * (q + 1) : r * (q + 1) + (xcd - r) * q) + off; }
        const int nig = WGM * nN, gid = wgid / nig, fm = gid * WGM, gsz = (nM - fm) < WGM ? (nM - fm) : WGM;
        u.pm = fm + ((wgid % nig) % gsz); u.pn = (wgid % nig) / gsz; return true;
    }
    __device__ __forceinline__ void a_ready(const Unit&) const {}
    __device__ __forceinline__ void done(const Unit&) const {}
};
__device__ __forceinline__ unsigned cvt_pk_bf16(float lo, float hi) { unsigned r; asm volatile("v_cvt_pk_bf16_f32 %0, %1, %2" : "=v"(r) : "v"(lo), "v"(hi)); return r; }
typedef float f32x2 __attribute__((ext_vector_type(2)));
typedef unsigned u32x2 __attribute__((ext_vector_type(2)));
#ifndef XN_TILED
#define XN_TILED 0
#endif
#ifndef T_TILED
#define T_TILED 0
#endif
#ifndef O_TILED
#define O_TILED 0
#endif
__device__ __forceinline__ size_t tix(size_t row, int col, int ktiles, bool tiled = true) { return tiled ? ((((row >> 8) * ktiles + (col >> 6)) << 14) + ((row & 255) << 6)) + (col & 63) : row * (size_t)(64 * ktiles) + col; }
__device__ __forceinline__ float bf_lo(unsigned w) { return __uint_as_float(w << 16); }
__device__ __forceinline__ float bf_hi(unsigned w) { return __uint_as_float(w & 0xffff0000u); }
__device__ __forceinline__ float sigm(float x) { return __builtin_amdgcn_rcpf(1.0f + __builtin_amdgcn_exp2f(-1.4426950408889634f * x)); }
constexpr int PROJ_LD = 2304;
__device__ __forceinline__ size_t gidx(int stage, int pm, int pt, int rowp, int col) { return ((((size_t)stage * 128 + pm) * 4 + pt) * 256 + rowp) * 256 + col; }
constexpr float QSCALE = 0.125f * 1.4426950408889634f;

__device__ __forceinline__ float row_rstd(const float* SS, size_t row) {
    const f32x4* p = (const f32x4*)(SS + row * 16);
    const f32x4 a = p[0], b = p[1], c = p[2], d = p[3];
    const float s = ((a[0] + a[1]) + (a[2] + a[3])) + ((b[0] + b[1]) + (b[2] + b[3])) + ((c[0] + c[1]) + (c[2] + c[3])) + ((d[0] + d[1]) + (d[2] + d[3]));
    return 1.0f / sqrtf(s * (1.0f / 1024.0f) + 1e-6f);
}
struct RowScale {
    const float* SS; const PG8_LAS float* tab; int pmA;
    __device__ __forceinline__ float get(const Unit& u, size_t row) const { return tab ? tab[(u.pm != pmA ? 256 : 0) + (int)(row & 255)] : row_rstd(SS, row); }
    __device__ __forceinline__ void get8(const Unit& u, int row0, float (&rs)[2][4]) const {
        if (__builtin_amdgcn_readfirstlane((int)(tab != nullptr))) {
            const PG8_LAS float* t = tab + (u.pm != pmA ? 256 : 0) + (row0 & 255);
#pragma unroll
            for (int ai = 0; ai < 2; ++ai)
#pragma unroll
                for (int m = 0; m < 4; ++m) rs[ai][m] = t[ai * HALF + m * 16];
        } else {
#pragma unroll
            for (int ai = 0; ai < 2; ++ai)
#pragma unroll
                for (int m = 0; m < 4; ++m) rs[ai][m] = row_rstd(SS, (size_t)(row0 + ai * HALF + m * 16));
        }
    }
};
template <bool SCALE> struct EpiSwiglu {
    static constexpr bool PERM = true, AFTER_DRAIN = false, PAIRED = false;
    bf16_t* H; int ldh; RowScale RS;
    __device__ __forceinline__ void operator()(const f32x4 (&acc)[2][2][4][2], const Unit& u, int wr, int wc, int fr, int fq) const {
        const int row0 = u.pm * BM + wr * 64 + fr, col0 = u.pn * HALF + wc * 32 + 8 * fq;
        float rsv[2][4];
        if (SCALE) RS.get8(u, row0, rsv);
#pragma unroll
        for (int ai = 0; ai < 2; ++ai)
#pragma unroll
            for (int m = 0; m < 4; ++m) {
                const size_t row = (size_t)(row0 + ai * HALF + m * 16);
                bf16_t* p = H + ((size_t)(u.pm * (ldh >> 6) + (col0 >> 6)) * BM + (row & (BM - 1))) * BK + (col0 & 63);
                f32x4 g0 = acc[ai][0][m][0], g1 = acc[ai][0][m][1], u0 = acc[ai][1][m][0], u1 = acc[ai][1][m][1];
                if (SCALE) { const float rs = rsv[ai][m]; g0 = g0 * rs; g1 = g1 * rs; u0 = u0 * rs; u1 = u1 * rs; }
                u32x4 w;
                w.x = cvt_pk_bf16(g0[0] * sigm(g0[0]) * u0[0], g0[1] * sigm(g0[1]) * u0[1]);
                w.y = cvt_pk_bf16(g0[2] * sigm(g0[2]) * u0[2], g0[3] * sigm(g0[3]) * u0[3]);
                w.z = cvt_pk_bf16(g1[0] * sigm(g1[0]) * u1[0], g1[1] * sigm(g1[1]) * u1[1]);
                w.w = cvt_pk_bf16(g1[2] * sigm(g1[2]) * u1[2], g1[3] * sigm(g1[3]) * u1[3]);
                __builtin_nontemporal_store(w, (u32x4*)p);
            }
    }
};
template <bool BASE_F32> struct EpiResidB {
    static constexpr bool PERM = true, AFTER_DRAIN = false, PAIRED = false;
    const void* base; bf16_t* X; float alpha; float* SS;
    __device__ __forceinline__ void operator()(const f32x4 (&acc)[2][2][4][2], const Unit& u, int wr, int wc, int fr, int fq) const {
        const int row0 = u.pm * BM + wr * 64 + fr, col0 = u.pn * BM + wc * 32 + 8 * fq;
#pragma unroll
        for (int ai = 0; ai < 2; ++ai) {
            f32x4 b0[4][2], b1[4][2];
            if (BASE_F32) {
#pragma unroll
                for (int m = 0; m < 4; ++m)
#pragma unroll
                    for (int bj = 0; bj < 2; ++bj) { const float* p = (const float*)base + (size_t)(row0 + ai * HALF + m * 16) * 1024 + col0 + bj * HALF; b0[m][bj] = __builtin_nontemporal_load((const f32x4*)p); b1[m][bj] = __builtin_nontemporal_load((const f32x4*)(p + 4)); }
            } else {
                u32x4 t[4][2];
#pragma unroll
                for (int m = 0; m < 4; ++m)
#pragma unroll
                    for (int bj = 0; bj < 2; ++bj) t[m][bj] = *(const u32x4*)((const bf16_t*)base + tix((size_t)(row0 + ai * HALF + m * 16), col0 + bj * HALF, 16, XN_TILED));
                __builtin_amdgcn_sched_barrier(0);
#pragma unroll
                for (int m = 0; m < 4; ++m)
#pragma unroll
                    for (int bj = 0; bj < 2; ++bj) { const u32x4 w = t[m][bj]; b0[m][bj] = (f32x4){bf_lo(w.x), bf_hi(w.x), bf_lo(w.y), bf_hi(w.y)}; b1[m][bj] = (f32x4){bf_lo(w.z), bf_hi(w.z), bf_lo(w.w), bf_hi(w.w)}; }
            }
            __builtin_amdgcn_sched_barrier(0);
#pragma unroll
            for (int m = 0; m < 4; ++m) {
                const size_t row = (size_t)(row0 + ai * HALF + m * 16);
                float ss = 0.f;
#pragma unroll
                for (int bj = 0; bj < 2; ++bj) {
                    const f32x4 v0 = b0[m][bj] + acc[ai][bj][m][0] * alpha, v1 = b1[m][bj] + acc[ai][bj][m][1] * alpha;
                    ss += ((v0[0] * v0[0] + v0[1] * v0[1]) + (v0[2] * v0[2] + v0[3] * v0[3])) + ((v1[0] * v1[0] + v1[1] * v1[1]) + (v1[2] * v1[2] + v1[3] * v1[3]));
                    u32x4 w; w.x = cvt_pk_bf16(v0[0], v0[1]); w.y = cvt_pk_bf16(v0[2], v0[3]); w.z = cvt_pk_bf16(v1[0], v1[1]); w.w = cvt_pk_bf16(v1[2], v1[3]);
                    *(u32x4*)(X + tix(row, col0 + bj * HALF, 16, XN_TILED)) = w;
                }
                ss += __shfl_xor(ss, 16); ss += __shfl_xor(ss, 32);
                if (fq == 0) SS[row * 16 + u.pn * 4 + wc] = ss;
            }
        }
    }
};
struct EpiProjIn {
    static constexpr bool PERM = true, AFTER_DRAIN = false, PAIRED = false;
    bf16_t* P; bf16_t* GT; RowScale RS;
    __device__ __forceinline__ void operator()(const f32x4 (&acc)[2][2][4][2], const Unit& u, int wr, int wc, int fr, int fq) const {
        const int row0 = u.pm * BM + wr * 64 + fr;
        const int kind = (u.pn < 2 || u.pn == 6 || u.pn == 7) ? 1 : (u.pn >= 9 ? 2 : 0);
        float rsv[2][4]; RS.get8(u, row0, rsv);
#pragma unroll
        for (int ai = 0; ai < 2; ++ai)
#pragma unroll
            for (int m = 0; m < 4; ++m) {
                const size_t row = (size_t)(row0 + ai * HALF + m * 16);
                const float rs = rsv[ai][m];
                if (kind == 2) {
                    const int gp = u.pn - 9;
                    bf16_t* p = GT + gidx(0, u.pm, gp >> 1, (int)(row & 255), (gp & 1) * HALF + wc * 32 + 8 * fq);
                    float rr[8], sb[8];
#pragma unroll
                    for (int n = 0; n < 2; ++n)
#pragma unroll
                        for (int j = 0; j < 4; ++j) {
                            const float ga = __builtin_fmaxf(acc[ai][0][m][n][j] * rs, -30.f), gb = __builtin_fmaxf(acc[ai][1][m][n][j] * rs, -30.f);
                            const float ea = __builtin_amdgcn_exp2f(-1.4426950408889634f * ga), eb = __builtin_amdgcn_exp2f(-1.4426950408889634f * gb);
                            rr[n * 4 + j] = (1.0f + eb) * __builtin_amdgcn_rcpf(1.0f + ea); sb[n * 4 + j] = __builtin_amdgcn_rcpf(1.0f + eb);
                        }
                    u32x4 w; w.x = cvt_pk_bf16(rr[0], rr[1]); w.y = cvt_pk_bf16(rr[2], rr[3]); w.z = cvt_pk_bf16(rr[4], rr[5]); w.w = cvt_pk_bf16(rr[6], rr[7]);
                    __builtin_nontemporal_store(w, (u32x4*)p);
                    w.x = cvt_pk_bf16(sb[0], sb[1]); w.y = cvt_pk_bf16(sb[2], sb[3]); w.z = cvt_pk_bf16(sb[4], sb[5]); w.w = cvt_pk_bf16(sb[6], sb[7]);
                    __builtin_nontemporal_store(w, (u32x4*)(p + gidx(1, 0, 0, 0, 0)));
                } else {
                    bf16_t* p = P + row * PROJ_LD + u.pn * BM + wc * 32 + 8 * fq;
                    const float sc = kind == 1 ? rs * QSCALE : rs;
#pragma unroll
                    for (int bj = 0; bj < 2; ++bj) {
                        const f32x4 v0 = acc[ai][bj][m][0] * sc, v1 = acc[ai][bj][m][1] * sc;
                        u32x4 w; w.x = cvt_pk_bf16(v0[0], v0[1]); w.y = cvt_pk_bf16(v0[2], v0[3]); w.z = cvt_pk_bf16(v1[0], v1[1]); w.w = cvt_pk_bf16(v1[2], v1[3]);
                        __builtin_nontemporal_store(w, (u32x4*)(p + bj * HALF));
                    }
                }
            }
    }
};
struct PairOrder {
    StaticOrder base;
    __host__ __device__ void init(int M, int N, int G_, int c_) { base.init(M, N, G_, c_); }
    __host__ __device__ bool next(int i, Unit& u) const { Unit b; if (!base.next(i >> 1, b)) return false; u.pm = b.pm + (i & 1) * base.nM; u.pn = b.pn + (i & 1) * base.nN; return true; }
    __device__ __forceinline__ void a_ready(const Unit&) const {}
    __device__ __forceinline__ void done(const Unit&) const {}
};
struct EpiGatePair {
    static constexpr bool PERM = true, AFTER_DRAIN = false, PAIRED = true;
    const bf16_t* P; bf16_t* T;
    __device__ __forceinline__ void operator()(f32x4 (&acc)[2][2][4][2], const Unit& u, int wr, int wc, int fr, int fq) const {
        const int stage = u.pm >= 128 ? 1 : 0, pm = u.pm & 127, pn = u.pn & 3;
        const int row0 = pm * BM + wr * 64 + fr, col0 = pn * BM + wc * 32 + 8 * fq;
        u32x4 gt[2][4][2];
#pragma unroll
        for (int ai = 0; ai < 2; ++ai)
#pragma unroll
            for (int m = 0; m < 4; ++m)
#pragma unroll
                for (int bj = 0; bj < 2; ++bj) gt[ai][m][bj] = *(const u32x4*)(P + gidx(stage, pm, pn, wr * 64 + fr + ai * HALF + m * 16, wc * 32 + 8 * fq + bj * HALF));
        __builtin_amdgcn_sched_barrier(0);
#pragma unroll
        for (int ai = 0; ai < 2; ++ai)
#pragma unroll
            for (int m = 0; m < 4; ++m) {
                const size_t row = (size_t)(row0 + ai * HALF + m * 16);
#pragma unroll
                for (int bj = 0; bj < 2; ++bj) {
                    const int c = col0 + bj * HALF;
                    const u32x4 g = gt[ai][m][bj];
                    f32x4 v0 = acc[ai][bj][m][0], v1 = acc[ai][bj][m][1];
                    v0[0] *= bf_lo(g.x); v0[1] *= bf_hi(g.x); v0[2] *= bf_lo(g.y); v0[3] *= bf_hi(g.y);
                    v1[0] *= bf_lo(g.z); v1[1] *= bf_hi(g.z); v1[2] *= bf_lo(g.w); v1[3] *= bf_hi(g.w);
                    if (stage == 0) { acc[ai][bj][m][0] = v0; acc[ai][bj][m][1] = v1; }
                    else { u32x4 w; w.x = cvt_pk_bf16(v0[0], v0[1]); w.y = cvt_pk_bf16(v0[2], v0[3]); w.z = cvt_pk_bf16(v1[0], v1[1]); w.w = cvt_pk_bf16(v1[2], v1[3]);
                           *(u32x4*)(T + tix(row, c, 16, T_TILED)) = w; }
                }
            }
    }
};
template <class Epi, class Sched, bool ALIGN_EPI = false, bool SP2 = false, bool NTA = false  >
__device__ __forceinline__ void gemm_phase(PG8_LAS unsigned char* lds, const Gemm g, const Sched& S, const Epi& E) {
    int tid_ = threadIdx.x; asm volatile("" : "+v"(tid_));
    const int tid = tid_, wid = __builtin_amdgcn_readfirstlane(tid >> 6), lane = tid & 63, wr = wid >> 2, wc = wid & 3, fr = lane & 15, fq = lane >> 4;
    const int K = g.K, nt = K / BK;
    unsigned voffA[2], voffB[2];
#pragma unroll
    for (int i = 0; i < 2; ++i) { int R, C; stage_rc(tid * 16 + i * 8192, R, C); const int Rb = Epi::PERM ? ((R & ~31) + perm32(R & 31)) : R;
        voffA[i] = g.tiledA ? (unsigned)(R * BK + C) * 2u : (unsigned)(R * K + C) * 2u; voffB[i] = g.tiledB ? (unsigned)(Rb * BK + C) * 2u : (unsigned)(Rb * K + C) * 2u; }
    const size_t kstep = (size_t)(BK * 2);
    const size_t hstep = (size_t)HALF * K * 2;
    const size_t tstep = 2 * hstep;
    const size_t kstepA = g.tiledA ? (size_t)(BM * BK * 2) : kstep, hstepA = g.tiledA ? (size_t)(HALF * BK * 2) : hstep, tstepA = g.tiledA ? (size_t)nt * (BM * BK * 2) : tstep;
    const size_t kstepB = g.tiledB ? (size_t)(BM * BK * 2) : kstep, hstepB = g.tiledB ? (size_t)(HALF * BK * 2) : hstep, tstepB = g.tiledB ? (size_t)nt * (BM * BK * 2) : tstep;
    const unsigned ldsw = (unsigned)wid * 1024u;
    const int aoff = lds_byte(wr * 64 + fr, fq * 8), boff = lds_byte(wc * 32 + fr, fq * 8);
#define PG8_SA(b, h) (((b) * 2 + (h)) * HTB)
#define PG8_SB(b, h) ((4 + (b) * 2 + (h)) * HTB)
#define PG8_STAGE(bufoff, gbase, voff) do { _Pragma("unroll") for (int _i = 0; _i < 2; ++_i) \
        __builtin_amdgcn_global_load_lds((const unsigned*)((const char*)(gbase) + (voff)[_i]), (PG8_LAS unsigned*)(lds + (bufoff) + ldsw + _i * 8192), 16, 0, 0); } while (0)
#define PG8_STAGEA(bufoff, gbase, voff) do { _Pragma("unroll") for (int _i = 0; _i < 2; ++_i) { \
        if constexpr (NTA) __builtin_amdgcn_global_load_lds((const unsigned*)((const char*)(gbase) + (voff)[_i]), (PG8_LAS unsigned*)(lds + (bufoff) + ldsw + _i * 8192), 16, 0, 2); \
        else __builtin_amdgcn_global_load_lds((const unsigned*)((const char*)(gbase) + (voff)[_i]), (PG8_LAS unsigned*)(lds + (bufoff) + ldsw + _i * 8192), 16, 0, 0); } } while (0)
#define PG8_LDA(dst, b, h) do { _Pragma("unroll") for (int m = 0; m < 4; ++m) _Pragma("unroll") for (int k = 0; k < 2; ++k) dst[m][k] = *(const PG8_LAS bf16x8*)(lds + PG8_SA(b, h) + aoff + m * 2048 + k * 1024); } while (0)
#define PG8_LDB(dst, b, h) do { _Pragma("unroll") for (int n = 0; n < 2; ++n) _Pragma("unroll") for (int k = 0; k < 2; ++k) dst[n][k] = *(const PG8_LAS bf16x8*)(lds + PG8_SB(b, h) + boff + n * 2048 + k * 1024); } while (0)
#define PG8_MMA(ai, bj, At, Bt) do { __builtin_amdgcn_s_setprio(1); _Pragma("unroll") for (int m = 0; m < 4; ++m) _Pragma("unroll") for (int n = 0; n < 2; ++n) _Pragma("unroll") for (int k = 0; k < 2; ++k) \
        acc[ai][bj][m][n] = __builtin_amdgcn_mfma_f32_16x16x32_bf16(Bt[n][k], At[m][k], acc[ai][bj][m][n], 0, 0, 0); __builtin_amdgcn_s_setprio(0); } while (0)
#define PG8_WAIT_V(n) asm volatile("s_waitcnt vmcnt(" #n ")" ::: "memory")
#define PG8_WAIT_L(n) asm volatile("s_waitcnt lgkmcnt(" #n ")" ::: "memory")
#define PG8_BAR __builtin_amdgcn_s_barrier()
#define PG8_SCHED __builtin_amdgcn_sched_barrier(0)
    Unit cur, nxt; int ui = 0;
    if (!S.next(0, cur)) return;
    f32x4 acc[2][2][4][2];
#pragma unroll
    for (int a = 0; a < 2; ++a)
#pragma unroll
        for (int b = 0; b < 2; ++b)
#pragma unroll
            for (int m = 0; m < 4; ++m)
#pragma unroll
                for (int n = 0; n < 2; ++n) acc[a][b][m][n] = (f32x4){0.f, 0.f, 0.f, 0.f};
    bf16x8 At[4][2], B0[2][2], B1[2][2];
    const char* cA = (const char*)g.A + (size_t)cur.pm * tstepA; const char* cB = (const char*)g.Bt + (size_t)cur.pn * tstepB;
    S.a_ready(cur);
    if constexpr (SP2) {
        PG8_STAGE(PG8_SB(0, 0), cB, voffB); PG8_STAGE(PG8_SB(0, 1), cB + hstepB, voffB); PG8_STAGEA(PG8_SA(0, 0), cA, voffA); PG8_STAGEA(PG8_SA(0, 1), cA + hstepA, voffA);
        if (wr == 1) PG8_BAR;
        PG8_WAIT_V(2); PG8_BAR;
        PG8_STAGE(PG8_SB(1, 0), cB + kstepB, voffB); PG8_STAGEA(PG8_SA(1, 0), cA + kstepA, voffA); PG8_STAGE(PG8_SB(1, 1), cB + hstepB + kstepB, voffB);
        PG8_WAIT_V(6); PG8_BAR;
    } else {
        PG8_STAGE(PG8_SB(0, 0), cB, voffB); PG8_STAGEA(PG8_SA(0, 0), cA, voffA); PG8_STAGE(PG8_SB(0, 1), cB + hstepB, voffB); PG8_STAGEA(PG8_SA(0, 1), cA + hstepA, voffA);
        if (wr == 1) PG8_BAR;
        PG8_WAIT_V(4); PG8_BAR;
        PG8_STAGE(PG8_SB(1, 0), cB + kstepB, voffB); PG8_STAGEA(PG8_SA(1, 0), cA + kstepA, voffA); PG8_STAGE(PG8_SB(1, 1), cB + hstepB + kstepB, voffB);
        PG8_WAIT_V(6); PG8_BAR;
    }
    for (;;) {
        const bool has_next = S.next(ui + 1, nxt);
        const char* nA = has_next ? (const char*)g.A + (size_t)nxt.pm * tstepA : cA; const char* nB = has_next ? (const char*)g.Bt + (size_t)nxt.pn * tstepB : cB;
        for (int t = 0; t < nt; t += 2) {
            const bool last = (t == nt - 2);
            const char* a1 = cA + (size_t)(t + 1) * kstepA;
            const char* a2 = last ? nA : cA + (size_t)(t + 2) * kstepA; const char* b2 = last ? nB : cB + (size_t)(t + 2) * kstepB;
            const char* a3 = a2 + kstepA; const char* b3 = b2 + kstepB;
            if (last && has_next) S.a_ready(nxt);
            if constexpr (SP2) {
            PG8_LDB(B0, 0, 0); PG8_LDB(B1, 0, 1); PG8_SCHED; PG8_LDA(At, 0, 0); PG8_STAGEA(PG8_SA(1, 1), a1 + hstepA, voffA);
            PG8_WAIT_V(8); PG8_WAIT_L(0); PG8_BAR; PG8_MMA(0, 0, At, B0); PG8_MMA(0, 1, At, B1); PG8_BAR; PG8_SCHED;
            PG8_LDA(At, 0, 1); PG8_STAGE(PG8_SB(0, 0), b2, voffB); PG8_STAGE(PG8_SB(0, 1), b2 + hstepB, voffB); PG8_STAGEA(PG8_SA(0, 0), a2, voffA);
            PG8_WAIT_V(8); PG8_WAIT_L(0); PG8_BAR; PG8_MMA(1, 0, At, B0); PG8_MMA(1, 1, At, B1); PG8_BAR; PG8_SCHED;
            PG8_LDB(B0, 1, 0); PG8_LDB(B1, 1, 1); PG8_SCHED; PG8_LDA(At, 1, 0); PG8_STAGEA(PG8_SA(0, 1), a2 + hstepA, voffA);
            PG8_WAIT_V(8); PG8_WAIT_L(0); PG8_BAR; PG8_MMA(0, 0, At, B0); PG8_MMA(0, 1, At, B1); PG8_BAR; PG8_SCHED;
            PG8_LDA(At, 1, 1); PG8_STAGE(PG8_SB(1, 0), b3, voffB); PG8_STAGE(PG8_SB(1, 1), b3 + hstepB, voffB); PG8_STAGEA(PG8_SA(1, 0), a3, voffA);
            PG8_WAIT_V(8); PG8_WAIT_L(0); PG8_BAR; PG8_MMA(1, 0, At, B0); PG8_MMA(1, 1, At, B1); PG8_BAR; PG8_SCHED;
            } else {
            PG8_LDB(B0, 0, 0); PG8_SCHED; PG8_LDA(At, 0, 0); PG8_STAGEA(PG8_SA(1, 1), a1 + hstepA, voffA);
            PG8_WAIT_L(8); PG8_BAR; PG8_WAIT_L(0); PG8_MMA(0, 0, At, B0); PG8_BAR; PG8_SCHED;
            PG8_LDB(B1, 0, 1); PG8_STAGE(PG8_SB(0, 0), b2, voffB);
            PG8_BAR; PG8_WAIT_L(0); PG8_MMA(0, 1, At, B1); PG8_BAR;
            PG8_LDA(At, 0, 1); PG8_STAGEA(PG8_SA(0, 0), a2, voffA);
            PG8_BAR; PG8_WAIT_L(0); PG8_MMA(1, 0, At, B0); PG8_BAR; PG8_SCHED;
            PG8_STAGE(PG8_SB(0, 1), b2 + hstepB, voffB);
            PG8_WAIT_V(6); PG8_BAR; PG8_MMA(1, 1, At, B1); PG8_BAR;
            PG8_LDB(B0, 1, 0); PG8_SCHED; PG8_LDA(At, 1, 0); PG8_STAGEA(PG8_SA(0, 1), a2 + hstepA, voffA);
            PG8_WAIT_L(8); PG8_BAR; PG8_WAIT_L(0); PG8_MMA(0, 0, At, B0); PG8_BAR; PG8_SCHED;
            PG8_LDB(B1, 1, 1); PG8_STAGE(PG8_SB(1, 0), b3, voffB);
            PG8_BAR; PG8_WAIT_L(0); PG8_MMA(0, 1, At, B1); PG8_BAR;
            PG8_LDA(At, 1, 1); PG8_STAGEA(PG8_SA(1, 0), a3, voffA);
            PG8_BAR; PG8_WAIT_L(0); PG8_MMA(1, 0, At, B0); PG8_BAR; PG8_SCHED;
            PG8_STAGE(PG8_SB(1, 1), b3 + hstepB, voffB);
            PG8_WAIT_V(6); PG8_BAR; PG8_MMA(1, 1, At, B1); PG8_BAR;
            }
        }
        if constexpr (ALIGN_EPI) { if (wr == 0) PG8_BAR; }
        if constexpr (!Epi::AFTER_DRAIN) { E(acc, cur, wr, wc, fr, fq); S.done(cur); }
        if (!has_next) break;
        if (!(Epi::PAIRED && (ui & 1) == 0)) {
#pragma unroll
        for (int a = 0; a < 2; ++a)
#pragma unroll
            for (int b = 0; b < 2; ++b)
#pragma unroll
                for (int m = 0; m < 4; ++m)
#pragma unroll
                    for (int n = 0; n < 2; ++n) acc[a][b][m][n] = (f32x4){0.f, 0.f, 0.f, 0.f};
        }
        cur = nxt; cA = nA; cB = nB; ++ui;
        if constexpr (ALIGN_EPI) { if (wr == 1) PG8_BAR; }
    }
    PG8_WAIT_V(0);
    if constexpr (!ALIGN_EPI) { if (wr == 0) PG8_BAR; }
    PG8_BAR;
    if constexpr (Epi::AFTER_DRAIN) { E.fused(acc, cur, wr, wc, fr, fq, lds, wid, lane); S.done(cur); }
#undef PG8_SA
#undef PG8_SB
#undef PG8_STAGE
#undef PG8_STAGEA
#undef PG8_LDA
#undef PG8_LDB
#undef PG8_MMA
#undef PG8_WAIT_V
#undef PG8_WAIT_L
#undef PG8_BAR
#undef PG8_SCHED
}
}
#define LAS __attribute__((address_space(3)))
typedef unsigned short bf16_t;
typedef short bf16x8 __attribute__((ext_vector_type(8)));
typedef short s16x4 __attribute__((ext_vector_type(4)));
typedef float f32x4 __attribute__((ext_vector_type(4)));
typedef float f32x16 __attribute__((ext_vector_type(16)));
typedef unsigned u32x4 __attribute__((ext_vector_type(4)));
typedef unsigned u32x2 __attribute__((ext_vector_type(2)));

constexpr int NB = 16, SEQ = 2048, DM = 1024, FF = 2816, NIN = 4352, M = NB * SEQ;
constexpr int NWAVES = 8;
constexpr float EPS = 1e-6f, LOG2E = 1.4426950408889634f;
constexpr size_t MiB = 1u << 20;
constexpr size_t WS_WF1 = 1 * MiB, WS_WD1 = 12 * MiB, WS_WIN = 18 * MiB, WS_WPA = 27 * MiB, WS_WPB = 28 * MiB, WS_WOUT = 29 * MiB, WS_WF2 = 31 * MiB, WS_WD2 = 42 * MiB;
constexpr size_t WS_XN = 48 * MiB, WS_BIG = 112 * MiB, WS_OA = 384 * MiB, WS_OB = 416 * MiB, WS_SS1 = 448 * MiB, WS_SS2 = 450 * MiB, WS_END = 452 * MiB;
static_assert(WS_WD2 + (size_t)DM * FF * 2 <= WS_XN && WS_BIG + (size_t)M * NIN * 2 <= WS_OA, "d_ws map");
constexpr int RING_BYTES = 131072, LDS_BYTES = 147456, MISC_OFF = RING_BYTES + 256;
constexpr size_t WS_BAR = 0, BAR_ZERO_BYTES = 16384;

__device__ __forceinline__ float wave_sum(float v) {
#pragma unroll
    for (int o = 1; o < 64; o <<= 1) v += __shfl_xor(v, o);
    return v;
}
__device__ __forceinline__ unsigned f2bf(float f) { unsigned u = __builtin_bit_cast(unsigned, f); return (u + 0x7fffu + ((u >> 16) & 1u)) >> 16; }
__device__ __forceinline__ unsigned pk2(float lo, float hi) { return f2bf(lo) | (f2bf(hi) << 16); }

#define XB_TMO      128
#define XB_XCNT(j)  (256  + 64 * (j))
#define XB_XSUB(j)  (1280 + 64 * (j))
#define XB_XGEN(j)  (2304 + 64 * (j))
#define XB_TOP      3328
#define XB_TOPGEN   3392
#define XCD_BAR_WORDS 3456
#define XB_SPIN_CAP (1u << 18)

__device__ __forceinline__ unsigned xb_ld(unsigned* p)              { return __hip_atomic_load(p, __ATOMIC_RELAXED, __HIP_MEMORY_SCOPE_AGENT); }
__device__ __forceinline__ unsigned xb_add(unsigned* p, unsigned v) { return __hip_atomic_fetch_add(p, v, __ATOMIC_RELAXED, __HIP_MEMORY_SCOPE_AGENT); }
__device__ __forceinline__ unsigned xb_xcc_id() { return (unsigned)__builtin_amdgcn_s_getreg((3 << 11) | 20) & 0xFu; }
#define XB_SPIN(cond, bar) do { unsigned _sp = 0; while (cond) { __builtin_amdgcn_s_sleep(1); \
    if ((++_sp & 255u) == 0u) { if (xb_ld(&(bar)[XB_TMO])) break; if (_sp > XB_SPIN_CAP) { atomicAdd(&(bar)[XB_TMO], 1u); break; } } } } while (0)

struct XcdBarrier {
    unsigned* bar; unsigned x;
    volatile LAS unsigned* st;
};

__device__ __forceinline__ XcdBarrier xcd_barrier_post(unsigned* bar, volatile LAS unsigned* st) {
    XcdBarrier b; b.bar = bar; b.x = xb_xcc_id(); b.st = st;
    if (threadIdx.x == 0) (void)xb_add(&bar[XB_XCNT(b.x)], 1u);
    return b;
}
__device__ __forceinline__ void xcd_barrier_complete(unsigned* bar, unsigned x, unsigned& nloc, unsigned& nx) {
    const unsigned G = gridDim.x * gridDim.y * gridDim.z;
    unsigned sum, cnt, mine, sp = 0u;
    for (;;) {
        sum = 0u; cnt = 0u; mine = 0u;
#pragma unroll
        for (unsigned j = 0; j < 16; ++j) { const unsigned c = xb_ld(&bar[XB_XCNT(j)]); sum += c; cnt += (c > 0u) ? 1u : 0u; mine = (j == x) ? c : mine; }
        if (sum == G) break;
        __builtin_amdgcn_s_sleep(1);
        if ((++sp & 255u) == 0u) { if (xb_ld(&bar[XB_TMO])) break; if (sp > XB_SPIN_CAP) { atomicAdd(&bar[XB_TMO], 1u); break; } }
    }
    nloc = mine > 0u ? mine : 1u; nx = cnt > 0u ? cnt : 1u;
}

__device__ __forceinline__ void xcd_barrier(const XcdBarrier& b) {
    asm volatile("s_waitcnt vmcnt(0)" ::: "memory");
    __syncthreads();
    if (threadIdx.x == 0) {
        unsigned* bar = b.bar;
        __builtin_amdgcn_s_waitcnt(0);
        unsigned nloc = b.st[0], nx = b.st[1];
        if (nloc == 0u) { xcd_barrier_complete(bar, b.x, nloc, nx); b.st[0] = nloc; b.st[1] = nx; }
        const unsigned old = xb_add(&bar[XB_XSUB(b.x)], 1u);
        const unsigned gen = old / nloc;
        if (old + 1u == (gen + 1u) * nloc) {
            __builtin_amdgcn_fence(__ATOMIC_RELEASE, "agent");
            asm volatile("s_waitcnt vmcnt(0)" ::: "memory");
            const unsigned og = xb_add(&bar[XB_TOP], 1u);
            const unsigned tg = og / nx;
            if (og + 1u == (tg + 1u) * nx) xb_add(&bar[XB_TOPGEN], 1u);
            else XB_SPIN(xb_ld(&bar[XB_TOPGEN]) == tg, bar);
            __builtin_amdgcn_fence(__ATOMIC_ACQUIRE, "agent");
            xb_add(&bar[XB_XGEN(b.x)], 1u);
            asm volatile("s_waitcnt vmcnt(0)" ::: "memory");
        } else {
            XB_SPIN(xb_ld(&bar[XB_XGEN(b.x)]) == gen, bar);
            __builtin_amdgcn_fence(__ATOMIC_ACQUIRE, "agent");
            asm volatile("s_waitcnt vmcnt(0)" ::: "memory");
        }
    }
    __syncthreads();
}

__device__ __forceinline__ void transpose_item(const float* W, int K, int N, bf16_t* WT, int ilv, const float* gain, LAS float* scr, int item, int lane) {
    const int nblk = N / 32, kb = item / nblk, nb = item % nblk, k0 = 64 * kb, n0 = 32 * nb;
    int rbase = n0; const int il = ilv & 7;
    if (il == 1 || il == 2) rbase = (n0 >> 7) * 256 + (n0 & 127) + (il == 2 ? 128 : 0);
    else if (il == 3 && n0 >= 2304) { const int jg = (n0 - 2304) & 1023; rbase = 2304 + (jg >> 7) * 256 + (jg & 127) + (n0 >= 3328 ? 128 : 0); }
#pragma unroll
    for (int i = 0; i < 32; ++i) { const int kk = 2 * i + (lane >> 5); const float gk = gain ? gain[k0 + kk] : 1.0f; scr[kk * 33 + (lane & 31)] = W[(size_t)(k0 + kk) * N + n0 + (lane & 31)] * gk; }
    asm volatile("s_waitcnt lgkmcnt(0)" ::: "memory");
    const int c = lane & 7;
#pragma unroll
    for (int j = 0; j < 4; ++j) { const int n = (lane >> 3) + 8 * j; const LAS float* s = scr + (8 * c) * 33 + n;
        u32x4 o; o.x = pk2(s[0 * 33], s[1 * 33]); o.y = pk2(s[2 * 33], s[3 * 33]); o.z = pk2(s[4 * 33], s[5 * 33]); o.w = pk2(s[6 * 33], s[7 * 33]);
        const int rown = rbase + n;
        bf16_t* dst = (ilv & 8) ? WT + ((size_t)((rown >> 8) * (K >> 6) + (k0 >> 6)) * 256 + (rown & 255)) * 64 + 8 * c : WT + (size_t)rown * K + k0 + 8 * c;
        *(u32x4*)dst = o; }
    asm volatile("s_waitcnt lgkmcnt(0)" ::: "memory");
}
__device__ __forceinline__ void rms_rows2_bf16(const float* xrow, bf16_t* XNb, size_t row, int lane) {
    const f32x4* xr = (const f32x4*)xrow + lane;
    f32x4 v[2][4]; float s[2] = {0.f, 0.f};
#pragma unroll
    for (int q = 0; q < 2; ++q)
#pragma unroll
        for (int j = 0; j < 4; ++j) v[q][j] = __builtin_nontemporal_load(xr + q * 256 + 64 * j);
#pragma unroll
    for (int q = 0; q < 2; ++q)
#pragma unroll
        for (int j = 0; j < 4; ++j) s[q] += (v[q][j].x * v[q][j].x + v[q][j].y * v[q][j].y) + (v[q][j].z * v[q][j].z + v[q][j].w * v[q][j].w);
#pragma unroll
    for (int q = 0; q < 2; ++q) {
        const float rstd = 1.0f / sqrtf(wave_sum(s[q]) * (1.0f / DM) + EPS);
#pragma unroll
        for (int j = 0; j < 4; ++j) { u32x2 w; w.x = pk2(v[q][j].x * rstd, v[q][j].y * rstd); w.y = pk2(v[q][j].z * rstd, v[q][j].w * rstd);
            *(u32x2*)(XNb + pg8::tix(row + q, 4 * lane + 256 * j, 16, XN_TILED)) = w; }
    }
}
__device__ __forceinline__ float bfl(unsigned w) { return __uint_as_float(w << 16); }
__device__ __forceinline__ float bfh(unsigned w) { return __uint_as_float(w & 0xffff0000u); }
__device__ __forceinline__ void final_rows2(const bf16_t* XNb, const float* SS, size_t row, const float* g, float* orow, int lane) {
    u32x4 t[2][2];
#pragma unroll
    for (int q = 0; q < 2; ++q)
#pragma unroll
        for (int hf = 0; hf < 2; ++hf) t[q][hf] = *(const u32x4*)(XNb + pg8::tix(row + q, hf * 512 + 8 * lane, 16, XN_TILED));
    f32x4 gv[2][2];
#pragma unroll
    for (int hf = 0; hf < 2; ++hf) { gv[hf][0] = *(const f32x4*)(g + hf * 512 + 8 * lane); gv[hf][1] = *(const f32x4*)(g + hf * 512 + 8 * lane + 4); }
#pragma unroll
    for (int q = 0; q < 2; ++q) {
        const f32x4* p = (const f32x4*)(SS + (row + q) * 16);
        const f32x4 a = p[0], b2 = p[1], c = p[2], d = p[3];
        const float s = ((a[0] + a[1]) + (a[2] + a[3])) + ((b2[0] + b2[1]) + (b2[2] + b2[3])) + ((c[0] + c[1]) + (c[2] + c[3])) + ((d[0] + d[1]) + (d[2] + d[3]));
        const float rstd = 1.0f / sqrtf(s * (1.0f / DM) + EPS);
#pragma unroll
        for (int hf = 0; hf < 2; ++hf) {
            const u32x4 w = t[q][hf];
            const f32x4 v0 = (f32x4){bfl(w.x), bfh(w.x), bfl(w.y), bfh(w.y)}, v1 = (f32x4){bfl(w.z), bfh(w.z), bfl(w.w), bfh(w.w)};
            float* o = orow + q * 1024 + hf * 512 + 8 * lane;
            __builtin_nontemporal_store(v0 * rstd * gv[hf][0], (f32x4*)o); __builtin_nontemporal_store(v1 * rstd * gv[hf][1], (f32x4*)(o + 4));
        }
    }
}

__device__ __forceinline__ int crow(int r, int hi) { return (r & 3) + 8 * (r >> 2) + 4 * hi; }
typedef float f32x2_t __attribute__((ext_vector_type(2))); typedef __bf16 bf16x2_t __attribute__((ext_vector_type(2)));
__device__ __forceinline__ unsigned cvtpk(float lo, float hi) { f32x2_t v = {lo, hi}; bf16x2_t b = __builtin_convertvector(v, bf16x2_t); return __builtin_bit_cast(unsigned, b); }
constexpr int VT_PITCH = 72, TAB_OFF = 64 * VT_PITCH;

__device__ __forceinline__ float xmax32(float v) {
    auto rr = __builtin_amdgcn_permlane32_swap(__float_as_uint(v), __float_as_uint(v), false, false);
    return __builtin_fmaxf(__uint_as_float(rr[0]), __uint_as_float(rr[1]));
}
typedef short v4i16_t __attribute__((ext_vector_type(4)));
constexpr float RESC_THR = 8.0f;
constexpr int KS_PITCH = 144, ATT_VT = 64 * KS_PITCH, ATT_BUF = 2 * 64 * KS_PITCH, ATT_TAB = 2 * ATT_BUF;
__device__ __forceinline__ void attn_first_ptrs(const bf16_t* PROJ, bool isB, int b, int hx, int cx, int tid, int lane, int wave, const bf16_t*& kp, const bf16_t*& vp, const bf16_t*& qp) {
    const int nprev = isB ? 2 : 8, j0 = cx < nprev ? nprev - cx : 0;
    const long srow = (long)b * SEQ + (cx - nprev + j0) * 64 + (tid >> 3);
    const bf16_t* base = PROJ + (size_t)srow * pg8::PROJ_LD + 8 * (tid & 7);
    kp = base + (isB ? 2048 + hx * 64 : 512 + hx * 64); vp = base + (isB ? 2176 + hx * 64 : 1024 + hx * 64);
    const int h = isB ? 4 * hx + (wave >> 1) : hx, cq = isB ? cx : cx + (wave >> 1);
    qp = PROJ + ((size_t)b * SEQ + cq * 64 + (wave & 1) * 32 + (lane & 31)) * pg8::PROJ_LD + (isB ? 1536 : 0) + h * 64 + 8 * (lane >> 5);
}
struct AttnNext { bool valid, isB; int b, hx, cx; };
template <bool IS_B>
__device__ __forceinline__ void attn_wg_unit(const bf16_t* __restrict__ PROJ, bf16_t* __restrict__ Oout, int b, int hx, int cx, LAS unsigned char* lds,
                                             const float* __restrict__ rel_bias, const float* __restrict__ sinks, int tid, int lane, int wave,
                                             bf16x8& kreg, bf16x8& vreg, bf16x8 (&qf)[4], const AttnNext nx) {
    constexpr int NPREV = IS_B ? 2 : 8, PP = pg8::PROJ_LD, NT = IS_B ? 3 : 12;
    const int r = lane & 31, hi = lane >> 5;
    const int ci = IS_B ? 0 : (wave >> 1), qh = wave & 1;
    const int h = IS_B ? 4 * hx + (wave >> 1) : hx;
    const int cq = cx + ci;
    const int qcol = IS_B ? 1536 + h * 64 : h * 64;
    const int kcol = IS_B ? 2048 + hx * 64 : 512 + hx * 64;
    const int vcol = IS_B ? 2176 + hx * 64 : 1024 + hx * 64;
    const size_t tok0 = (size_t)b * SEQ;
    const int j0 = cx < NPREV ? NPREV - cx : 0;
    const int srow = tid >> 3, sch = tid & 7;
    const long srow0 = (long)tok0 + (cx - NPREV) * 64 + srow;
#define ATT_SRC(j, col) (PROJ + (size_t)(srow0 + (long)(j) * 64) * PP + 8 * sch + (col))
    bf16x8 qn[4];
    const bf16_t *nkp = nullptr, *nvp = nullptr, *nqp = nullptr;
    if (nx.valid) attn_first_ptrs(PROJ, nx.isB, nx.b, nx.hx, nx.cx, tid, lane, wave, nkp, nvp, nqp);
    const LAS float* tab = (const LAS float*)(lds + ATT_TAB) + (IS_B ? 0 : h * 192);
    float m, l, slope2 = 0.f;
    if (IS_B) { m = ((const LAS float*)(lds + ATT_TAB))[8 * 192 + h]; l = hi == 0 ? 1.f : 0.f; slope2 = LOG2E * __builtin_amdgcn_exp2f(-(float)(h + 1)); }
    else { m = -1e30f; l = 0.f; }
    f32x16 o[2];
#pragma unroll
    for (int d = 0; d < 2; ++d)
#pragma unroll
        for (int i = 0; i < 16; ++i) o[d][i] = 0.f;
    for (int j = j0; j < NT; ++j) {
        LAS unsigned char* buf = lds + (j & 1) * ATT_BUF;
        *(LAS bf16x8*)(buf + srow * KS_PITCH + sch * 16) = kreg;
        *(LAS bf16x8*)(buf + ATT_VT + srow * KS_PITCH + sch * 16) = vreg;
        if (j + 1 < NT) { kreg = *(const bf16x8*)ATT_SRC(j + 1, kcol); vreg = *(const bf16x8*)ATT_SRC(j + 1, vcol); }
        else if (nx.valid) {
            kreg = *(const bf16x8*)nkp; vreg = *(const bf16x8*)nvp;
#pragma unroll
            for (int s = 0; s < 4; ++s) qn[s] = *(const bf16x8*)(nqp + 16 * s);
        }
        asm volatile("s_waitcnt lgkmcnt(0)" ::: "memory"); __builtin_amdgcn_s_barrier(); asm volatile("" ::: "memory");
        const int dc = IS_B ? NPREV - j : ci + NPREV - j;
        if (IS_B || (dc >= 0 && dc <= NPREV)) {
            f32x16 sv[2];
#pragma unroll
            for (int kh = 0; kh < 2; ++kh) {
#pragma unroll
                for (int i = 0; i < 16; ++i) sv[kh][i] = 0.f;
#pragma unroll
                for (int st = 0; st < 4; ++st) {
                    const bf16x8 kfr = *(const LAS bf16x8*)(buf + (32 * kh + r) * KS_PITCH + (16 * st + 8 * hi) * 2);
                    sv[kh] = __builtin_amdgcn_mfma_f32_32x32x16_bf16(kfr, qf[st], sv[kh], 0, 0, 0);
                }
            }
            const bool cbias = !IS_B && dc >= 3;
            const float cb = cbias ? tab[191] : 0.f;
            const int relq = 64 * dc + 32 * qh + r - 4 * hi;
            if (IS_B) {
                const float rf = (float)relq;
#pragma unroll
                for (int kh = 0; kh < 2; ++kh)
#pragma unroll
                    for (int i = 0; i < 16; ++i) sv[kh][i] -= slope2 * __builtin_fabsf(rf - (float)(32 * kh + (i & 3) + 8 * (i >> 2)));
            } else if (!cbias) {
#pragma unroll
                for (int kh = 0; kh < 2; ++kh)
#pragma unroll
                    for (int i = 0; i < 16; ++i) { int rel = relq - (32 * kh + (i & 3) + 8 * (i >> 2)); rel = rel > 128 ? 128 : rel; sv[kh][i] += tab[rel + 63]; }
            }
            float t0 = sv[0][0], t1 = sv[1][0];
#pragma unroll
            for (int i = 1; i < 16; i += 3) { t0 = __builtin_fmaxf(__builtin_fmaxf(t0, sv[0][i]), sv[0][i + 1]); t0 = __builtin_fmaxf(t0, sv[0][i + 2]); t1 = __builtin_fmaxf(__builtin_fmaxf(t1, sv[1][i]), sv[1][i + 1]); t1 = __builtin_fmaxf(t1, sv[1][i + 2]); }
            const float tm = xmax32(__builtin_fmaxf(t0, t1)) + cb;
            if (__any(tm > m + RESC_THR)) {
                const float mn = __builtin_fmaxf(m, tm);
                const float alpha = __builtin_amdgcn_exp2f(m - mn);
                m = mn; l *= alpha;
#pragma unroll
                for (int d = 0; d < 2; ++d)
#pragma unroll
                    for (int i = 0; i < 16; ++i) o[d][i] *= alpha;
            }
            const float off = m - cb;
            float ps0 = 0.f, ps1 = 0.f;
#pragma unroll
            for (int i = 0; i < 16; ++i) { sv[0][i] = __builtin_amdgcn_exp2f(sv[0][i] - off); sv[1][i] = __builtin_amdgcn_exp2f(sv[1][i] - off); ps0 += sv[0][i]; ps1 += sv[1][i]; }
            l += ps0 + ps1;
            bf16x8 pk[4];
#pragma unroll
            for (int ks = 0; ks < 4; ++ks) {
                const f32x16& s = sv[ks >> 1]; const int q0 = 8 * (ks & 1);
                u32x4 w; w.x = cvtpk(s[q0], s[q0 + 1]); w.y = cvtpk(s[q0 + 2], s[q0 + 3]); w.z = cvtpk(s[q0 + 4], s[q0 + 5]); w.w = cvtpk(s[q0 + 6], s[q0 + 7]);
                pk[ks] = __builtin_bit_cast(bf16x8, w);
            }
#pragma unroll
            for (int d = 0; d < 2; ++d)
#pragma unroll
                for (int ks = 0; ks < 4; ++ks) {
                    const LAS unsigned char* vb = buf + ATT_VT + (16 * ks + 4 * hi + ((lane & 15) >> 2)) * KS_PITCH + (32 * d + 16 * ((lane >> 4) & 1) + 4 * (lane & 3)) * 2;
                    const s16x4 lo = __builtin_bit_cast(s16x4, __builtin_amdgcn_ds_read_tr16_b64_v4i16((LAS v4i16_t*)vb));
                    const s16x4 hv = __builtin_bit_cast(s16x4, __builtin_amdgcn_ds_read_tr16_b64_v4i16((LAS v4i16_t*)(vb + 8 * KS_PITCH)));
                    const bf16x8 va = __builtin_shufflevector(lo, hv, 0, 1, 2, 3, 4, 5, 6, 7);
                    o[d] = __builtin_amdgcn_mfma_f32_32x32x16_bf16(va, pk[ks], o[d], 0, 0, 0);
                }
        }
    }
    {
        const float lt = l + __shfl_xor(l, 32);
        const float inv = 1.0f / lt;
        bf16_t* op = Oout + pg8::tix(tok0 + cq * 64 + qh * 32 + r, h * 64, 8, O_TILED) + 8 * hi;
#pragma unroll
        for (int d = 0; d < 2; ++d)
#pragma unroll
            for (int p = 0; p < 2; ++p) {
                const int g0 = 2 * p, g1 = 2 * p + 1;
                const unsigned ax = cvtpk(o[d][4 * g0] * inv, o[d][4 * g0 + 1] * inv), ay = cvtpk(o[d][4 * g0 + 2] * inv, o[d][4 * g0 + 3] * inv);
                const unsigned bx = cvtpk(o[d][4 * g1] * inv, o[d][4 * g1 + 1] * inv), by = cvtpk(o[d][4 * g1 + 2] * inv, o[d][4 * g1 + 3] * inv);
                const auto sx = __builtin_amdgcn_permlane32_swap(ax, bx, false, false);
                const auto sy = __builtin_amdgcn_permlane32_swap(ay, by, false, false);
                u32x4 w; w.x = sx[0]; w.y = sy[0]; w.z = sx[1]; w.w = sy[1];
                *(u32x4*)(op + 32 * d + 16 * p) = w;
            }
    }
#undef ATT_SRC
    if (nx.valid) {
#pragma unroll
        for (int s = 0; s < 4; ++s) qf[s] = qn[s];
    }
    asm volatile("s_waitcnt lgkmcnt(0)" ::: "memory"); __builtin_amdgcn_s_barrier(); asm volatile("" ::: "memory");
}
struct Args { const float* in[17]; float* out; unsigned char* ws; };
enum { I_X = 0, I_N1, I_G1, I_U1, I_D1, I_NM, I_WIN, I_RELB, I_SINK, I_WPA, I_WPB, I_WOUT, I_N2, I_G2, I_U2, I_D2, I_NF };


#define PREP_ROWSCALE(rs_, S_, SS_) do { \
        pg8::Unit u_; int pmA_ = -1, pmB_ = -1; bool multi_ = false; \
        for (int i_ = 0; (S_).next(i_, u_); ++i_) { if (pmA_ < 0) pmA_ = u_.pm; else if (u_.pm != pmA_) { if (pmB_ < 0) pmB_ = u_.pm; else if (u_.pm != pmB_) multi_ = true; } } \
        if (pmB_ < 0) pmB_ = pmA_; \
        LAS float* tab_ = (LAS float*)(lds + RING_BYTES + 1024); \
        (rs_).SS = (SS_); (rs_).pmA = pmA_; (rs_).tab = (multi_ || pmA_ < 0) ? nullptr : tab_; \
        if ((rs_).tab) { const size_t row_ = (size_t)((tid < 256) ? pmA_ : pmB_) * 256 + (tid & 255); tab_[tid] = pg8::row_rstd((SS_), row_); } \
        __syncthreads(); } while (0)
__global__ void __launch_bounds__(NWAVES * 64, 2) mega_fwd(Args a) {
    extern __shared__ __attribute__((aligned(16))) unsigned char lds_raw[];
    LAS unsigned char* lds = (LAS unsigned char*)lds_raw;
    cg::grid_group grid = cg::this_grid();
    const int tid = threadIdx.x, lane = tid & 63, wave = __builtin_amdgcn_readfirstlane(tid >> 6);
    const int G = gridDim.x, bx = blockIdx.x;
    const int gw = bx * NWAVES + wave, NGW = G * NWAVES;
    unsigned char* ws = a.ws;
    bf16_t* WF1 = (bf16_t*)(ws + WS_WF1); bf16_t* WD1 = (bf16_t*)(ws + WS_WD1); bf16_t* WIN = (bf16_t*)(ws + WS_WIN); bf16_t* WPA = (bf16_t*)(ws + WS_WPA);
    bf16_t* WPB = (bf16_t*)(ws + WS_WPB); bf16_t* WOUT = (bf16_t*)(ws + WS_WOUT); bf16_t* WF2 = (bf16_t*)(ws + WS_WF2); bf16_t* WD2 = (bf16_t*)(ws + WS_WD2);
    bf16_t* XN = (bf16_t*)(ws + WS_XN); bf16_t* BIG = (bf16_t*)(ws + WS_BIG); bf16_t* OA = (bf16_t*)(ws + WS_OA); bf16_t* OB = (bf16_t*)(ws + WS_OB);
    float* X = a.out;
    volatile LAS unsigned* MISC = (volatile LAS unsigned*)(lds + MISC_OFF);
    if (tid < 16) MISC[tid] = 0u;
    __syncthreads();
    XcdBarrier bar = xcd_barrier_post((unsigned*)(ws + WS_BAR), MISC + 8);
#define GRID_BAR() xcd_barrier(bar)

    float* SS1 = (float*)(ws + WS_SS1); float* SS2 = (float*)(ws + WS_SS2);
    bf16_t* T = (bf16_t*)a.out;
    {
        LAS float* scr = (LAS float*)(lds + wave * 16384);
        constexpr int I_FF = (DM / 64) * (FF / 32), I_DN = (FF / 64) * (DM / 32), I_IN = (DM / 64) * (NIN / 32);
        constexpr int NITEMS = 2 * I_FF + I_DN + I_IN;
        for (int it = gw; it < NITEMS; it += NGW) {
            int r = it;
            if (r < I_FF) { transpose_item(a.in[I_G1], DM, FF, WF1, 1 | 8, a.in[I_N1], scr, r, lane); continue; } r -= I_FF;
            if (r < I_FF) { transpose_item(a.in[I_U1], DM, FF, WF1, 2 | 8, a.in[I_N1], scr, r, lane); continue; } r -= I_FF;
            if (r < I_DN) { transpose_item(a.in[I_D1], FF, DM, WD1, 8, nullptr, scr, r, lane); continue; } r -= I_DN;
            transpose_item(a.in[I_WIN], DM, NIN, WIN, 3 | 8, a.in[I_NM], scr, r, lane);
        }
        for (int mrow = 2 * gw; mrow < M; mrow += 2 * NGW) rms_rows2_bf16(a.in[I_X] + (size_t)mrow * DM, XN, (size_t)mrow, lane);
    }
    if (a.ws == nullptr) grid.sync();
    GRID_BAR();
    { pg8::Gemm g{XN, WF1, M, 2 * FF, DM, XN_TILED, 1}; pg8::StaticOrder S; S.init(M, 2 * FF, G, bx); pg8::EpiSwiglu<false> E{BIG, FF, pg8::RowScale{nullptr, nullptr, 0}};
      pg8::gemm_phase<pg8::EpiSwiglu<false>, pg8::StaticOrder, true, true>(lds, g, S, E);
      DUP(1) pg8::gemm_phase<pg8::EpiSwiglu<false>, pg8::StaticOrder, true, true>(lds, g, S, E); }
    GRID_BAR();
    DUP(20) { GRID_BAR(); GRID_BAR(); GRID_BAR(); GRID_BAR(); GRID_BAR(); GRID_BAR(); GRID_BAR(); GRID_BAR(); }
    { pg8::Gemm g{BIG, WD1, M, DM, FF, 1, 1}; pg8::StaticOrder S; S.init(M, DM, G, bx); pg8::EpiResidB<true> E{a.in[I_X], XN, 0.5f, SS1};
      pg8::gemm_phase<pg8::EpiResidB<true>, pg8::StaticOrder, true, false>(lds, g, S, E);
      DUP(2) pg8::gemm_phase<pg8::EpiResidB<true>, pg8::StaticOrder, true, true>(lds, g, S, E); }
    GRID_BAR();
    { pg8::Gemm g{XN, WIN, M, NIN, DM, XN_TILED, 1}; pg8::StaticOrder S; S.init(M, NIN, G, bx); pg8::RowScale RS; PREP_ROWSCALE(RS, S, SS1); pg8::EpiProjIn E{BIG, BIG + (size_t)M * pg8::PROJ_LD, RS};
      pg8::gemm_phase<pg8::EpiProjIn, pg8::StaticOrder, true, true>(lds, g, S, E);
      DUP(4) pg8::gemm_phase<pg8::EpiProjIn, pg8::StaticOrder, true, true>(lds, g, S, E); }
    {
        constexpr int NU4 = (M / 256) * (NIN / 256);
        const int rounds = (NU4 + G - 1) / G, nbusy = NU4 - (rounds - 1) * G;
        const int nidle = G - nbusy;
        const bool all = (nidle <= 0);
        if (all || bx >= nbusy) {
            int t4 = threadIdx.x; asm volatile("" : "+v"(t4)); const int lane = t4 & 63, wave = __builtin_amdgcn_readfirstlane(t4 >> 6), gw = bx * NWAVES + wave;
            LAS float* scr = (LAS float*)(lds + wave * 16384);
            constexpr int I_FF = (DM / 64) * (FF / 32), I_DN = (FF / 64) * (DM / 32), I_P = (512 / 64) * (DM / 32), I_O = (DM / 64) * (DM / 32);
            constexpr int NLATE = 2 * I_P + I_O + 2 * I_FF + I_DN;
            const int w0 = all ? gw : (bx - nbusy) * NWAVES + wave, nw = all ? NGW : nidle * NWAVES;
            for (int it = w0; it < NLATE; it += nw) {
                int r = it;
                if (r < I_P) { transpose_item(a.in[I_WPA], 512, DM, WPA, 8, nullptr, scr, r, lane); continue; } r -= I_P;
                if (r < I_P) { transpose_item(a.in[I_WPB], 512, DM, WPB, 8, nullptr, scr, r, lane); continue; } r -= I_P;
                if (r < I_O) { transpose_item(a.in[I_WOUT], DM, DM, WOUT, 8, nullptr, scr, r, lane); continue; } r -= I_O;
                if (r < I_FF) { transpose_item(a.in[I_G2], DM, FF, WF2, 1 | 8, a.in[I_N2], scr, r, lane); continue; } r -= I_FF;
                if (r < I_FF) { transpose_item(a.in[I_U2], DM, FF, WF2, 2 | 8, a.in[I_N2], scr, r, lane); continue; } r -= I_FF;
                transpose_item(a.in[I_D2], FF, DM, WD2, 8, nullptr, scr, r, lane);
            }
        }
    }
    GRID_BAR();
    {
        const int vcu = (G % 8 == 0) ? (bx % 8) * (G / 8) + bx / 8 : bx;
        int tid5_ = threadIdx.x; asm volatile("" : "+v"(tid5_));
        const int tid = tid5_, lane = tid & 63, wave = __builtin_amdgcn_readfirstlane(tid >> 6);
#define ATT_DESC(u_, d_) do { const int uu_ = (u_); (d_).valid = uu_ < 2048; (d_).isB = uu_ >= 1024; \
            if (uu_ < 1024) { const int i_ = uu_ >> 8, w_ = uu_ & 255; (d_).b = (w_ >> 6) + 4 * i_; (d_).hx = (w_ >> 3) & 7; (d_).cx = 4 * (((w_ & 7) + 2 * i_) & 7); } \
            else { const int v_ = uu_ - 1024; (d_).b = v_ >> 6; (d_).hx = (v_ >> 5) & 1; (d_).cx = v_ & 31; } } while (0)
        {
            LAS float* tabs = (LAS float*)(lds + ATT_TAB);
            for (int i = tid; i < 8 * 192; i += NWAVES * 64) tabs[i] = a.in[I_RELB][i] * LOG2E;
            if (tid < 8) tabs[8 * 192 + tid] = a.in[I_SINK][tid] * LOG2E;
            __syncthreads();
        }
        for (int rep = 0; rep < (PROBE_DUP == 5 ? 2 : 1); ++rep) {
        AttnNext cur; ATT_DESC(vcu, cur);
        bf16x8 kreg, vreg, qf[4];
        if (cur.valid) { const bf16_t *kp, *vp, *qp; attn_first_ptrs(BIG, cur.isB, cur.b, cur.hx, cur.cx, tid, lane, wave, kp, vp, qp);
            kreg = *(const bf16x8*)kp; vreg = *(const bf16x8*)vp;
#pragma unroll
            for (int s = 0; s < 4; ++s) qf[s] = *(const bf16x8*)(qp + 16 * s); }
        for (int u = vcu; u < 2048; u += G) {
            AttnNext nx; ATT_DESC(u + G, nx);
            if (!cur.isB) attn_wg_unit<false>(BIG, OA, cur.b, cur.hx, cur.cx, lds, a.in[I_RELB], a.in[I_SINK], tid, lane, wave, kreg, vreg, qf, nx);
            else attn_wg_unit<true>(BIG, OB, cur.b, cur.hx, cur.cx, lds, a.in[I_RELB], a.in[I_SINK], tid, lane, wave, kreg, vreg, qf, nx);
            cur = nx;
        }
        }
#undef ATT_DESC
    }
    GRID_BAR();
    { pg8::Gemm g{OA, WPA, 2 * M, 2 * DM, 512, O_TILED, 1}; pg8::PairOrder S; S.init(M, DM, G, bx); pg8::EpiGatePair E{BIG + (size_t)M * pg8::PROJ_LD, T};
      pg8::gemm_phase<pg8::EpiGatePair, pg8::PairOrder, true, true>(lds, g, S, E);
      DUP(6) pg8::gemm_phase<pg8::EpiGatePair, pg8::PairOrder, true, true>(lds, g, S, E); }
    GRID_BAR();
    { pg8::Gemm g{T, WOUT, M, DM, DM, T_TILED, 1}; pg8::StaticOrder S; S.init(M, DM, G, bx); pg8::EpiResidB<false> E{XN, XN, 1.0f, SS2};
      pg8::gemm_phase<pg8::EpiResidB<false>, pg8::StaticOrder, true, true>(lds, g, S, E); }
    GRID_BAR();
    { pg8::Gemm g{XN, WF2, M, 2 * FF, DM, XN_TILED, 1}; pg8::StaticOrder S; S.init(M, 2 * FF, G, bx); pg8::RowScale RS; PREP_ROWSCALE(RS, S, SS2); pg8::EpiSwiglu<true> E{BIG, FF, RS};
      pg8::gemm_phase<pg8::EpiSwiglu<true>, pg8::StaticOrder, true, true>(lds, g, S, E);
      DUP(9) pg8::gemm_phase<pg8::EpiSwiglu<true>, pg8::StaticOrder, true, true>(lds, g, S, E); }
    GRID_BAR();
    { pg8::Gemm g{BIG, WD2, M, DM, FF, 1, 1}; pg8::StaticOrder S; S.init(M, DM, G, bx); pg8::EpiResidB<false> E{XN, XN, 0.5f, SS1};
      pg8::gemm_phase<pg8::EpiResidB<false>, pg8::StaticOrder, true, true>(lds, g, S, E); }
    GRID_BAR();
    { int t11 = threadIdx.x; asm volatile("" : "+v"(t11));
      const int lane11 = t11 & 63, gw11 = bx * NWAVES + __builtin_amdgcn_readfirstlane(t11 >> 6);
      for (int mrow = 2 * gw11; mrow < M; mrow += 2 * NGW) final_rows2(XN, SS1, (size_t)mrow, a.in[I_NF], X + (size_t)mrow * DM, lane11); }
}

extern "C" void kernel_launch(void* const* d_in, const int* in_sizes, int n_in, void* d_out, int out_size, void* d_ws, size_t ws_size, hipStream_t stream) {
    static int grid = 0;
    if (grid == 0) {
        if (n_in != 17 || in_sizes[0] != M * DM || out_size != M * DM || ws_size < WS_END) { fprintf(stderr, "kernel_launch: unexpected shapes (n_in %d, in0 %d, out %d, ws %zu)\n", n_in, n_in > 0 ? in_sizes[0] : -1, out_size, ws_size); grid = -1; return; }
        int dev = 0, cus = 0, per_cu = 0;
        (void)hipGetDevice(&dev);
        (void)hipDeviceGetAttribute(&cus, hipDeviceAttributeMultiprocessorCount, dev);
        if (hipFuncSetAttribute((const void*)mega_fwd, hipFuncAttributeMaxDynamicSharedMemorySize, LDS_BYTES) != hipSuccess) { fprintf(stderr, "kernel_launch: hipFuncSetAttribute failed\n"); grid = -1; return; }
        if (hipOccupancyMaxActiveBlocksPerMultiprocessor(&per_cu, (const void*)mega_fwd, NWAVES * 64, LDS_BYTES) != hipSuccess || per_cu < 1) { fprintf(stderr, "kernel_launch: occupancy query says %d\n", per_cu); per_cu = 1; }
        (void)hipGetLastError();
        grid = cus * 1;
        fprintf(stderr, "kernel_launch: grid %d (cus %d, per_cu %d)\n", grid, cus, per_cu);
    }
    if (grid < 0) return;
    if (hipMemsetAsync((char*)d_ws + WS_BAR, 0, BAR_ZERO_BYTES, stream) != hipSuccess) { fprintf(stderr, "kernel_launch: memset failed\n"); return; }
    Args a{};
    for (int i = 0; i < 17; ++i) a.in[i] = (const float*)d_in[i];
    a.out = (float*)d_out; a.ws = (unsigned char*)d_ws;
    void* args[] = {&a};
    hipError_t e = hipLaunchCooperativeKernel((const void*)mega_fwd, dim3(grid), dim3(NWAVES * 64), args, LDS_BYTES, stream);
    if (e != hipSuccess) fprintf(stderr, "kernel_launch: cooperative launch failed: %s (grid %d)\n", hipGetErrorString(e), grid);
}
```
